# Optimizing an MI355X kernel written in HIP

```python
import jax, jax.numpy as jnp
from jax import lax
import numpy as np

D_MODEL = 1024
BATCH = 32
SEQ = 2048
DEPTH = 1

HEAD_DIM = 64
DSA_HEADS = 8
DSA_Q_RANK = 256
DSA_KV_RANK = 128
IDX_HEADS = 4
IDX_DIM = 64
DSA_TOPK_MAX = 256
MOBA_HEADS = 8
MOBA_BLOCK = 256
MOBA_TOPK = 3
D_FF = 2816
N_MOD = 9
DSA_Q_CHUNK = 128
MOBA_Q_CHUNK = 16
EPS = 1e-6
DSA_WIDTH = DSA_HEADS * HEAD_DIM
MOBA_WIDTH = MOBA_HEADS * HEAD_DIM
IN_SPLITS = (DSA_Q_RANK, DSA_KV_RANK, IDX_DIM, IDX_HEADS, MOBA_WIDTH, MOBA_WIDTH, MOBA_WIDTH, D_MODEL, D_MODEL)
IN_WIDTH = DSA_Q_RANK + DSA_KV_RANK + IDX_DIM + IDX_HEADS + 3 * MOBA_WIDTH + 2 * D_MODEL

kernel_name = "hybrid_dsa_moba_macaron_adaln"


def rms_norm(x, g):
    xf = x.astype(jnp.float32)
    y = xf * lax.rsqrt(jnp.mean(xf * xf, axis=-1, keepdims=True) + EPS)
    return (y * g.astype(jnp.float32)).astype(x.dtype)


def layer_norm(x, g, b):
    xf = x.astype(jnp.float32)
    mu = jnp.mean(xf, axis=-1, keepdims=True)
    xc = xf - mu
    y = xc * lax.rsqrt(jnp.mean(xc * xc, axis=-1, keepdims=True) + EPS)
    return (y * g.astype(jnp.float32) + b.astype(jnp.float32)).astype(x.dtype)


def alibi_slopes(n):
    return 2.0 ** (-8.0 * (jnp.arange(n, dtype=jnp.float32) + 1.0) / n)


def modulate(h, shift, scale):
    return h * (1.0 + scale[:, None, :]) + shift[:, None, :]


def swiglu(h, w1, w3, w2):
    return (jax.nn.silu(h @ w1) * (h @ w3)) @ w2


def split_cols(p):
    offs, o = [], 0
    for w in IN_SPLITS[:-1]:
        o += w
        offs.append(o)
    return jnp.split(p, offs, axis=-1)


def dsa_attention(cq, ckv, k_idx, w_idx, w_uq, w_qidx, w_uk, w_uv):
    B, S, _ = cq.shape
    k_sel = min(DSA_TOPK_MAX, S // 4)
    qc = min(DSA_Q_CHUNK, S)
    n_chunks = S // qc
    slopes = alibi_slopes(DSA_HEADS)
    scale = HEAD_DIM ** -0.5
    q = jnp.einsum('bsr,rhd->bshd', cq, w_uq)
    q_lat = jnp.einsum('bshd,chd->bshc', q, w_uk) * scale
    q_idx = jnp.einsum('bsr,rhd->bshd', cq, w_qidx)
    w_idx = w_idx * (IDX_HEADS ** -0.5 * IDX_DIM ** -0.5)
    key_pos = jnp.arange(S)

    def chunked(a):
        return a.reshape((B, n_chunks, qc) + a.shape[2:]).swapaxes(0, 1)

    def step(args):
        ci, ql, qi, wi = args
        t = ci * qc + jnp.arange(qc)
        rel = jax.nn.relu(jnp.einsum('bqhd,bsd->bqhs', qi, k_idx))
        score = jnp.einsum('bqhs,bqh->bqs', rel, wi).astype(jnp.float32)
        score = jnp.where(key_pos[None, None, :] <= t[None, :, None], score, -jnp.inf)
        _, idx = lax.top_k(score, k_sel)
        kv = jax.vmap(lambda cc, ii: cc[ii])(ckv, idx)
        s = jnp.einsum('bqhc,bqkc->bqhk', ql, kv).astype(jnp.float32)
        dist = (t[None, :, None] - idx).astype(jnp.float32)
        s = s - slopes[None, None, :, None] * dist[:, :, None, :]
        s = jnp.where((dist >= 0)[:, :, None, :], s, -jnp.inf)
        p = jax.nn.softmax(s, axis=-1).astype(kv.dtype)
        return jnp.einsum('bqhk,bqkc->bqhc', p, kv)

    o_lat = lax.map(step, (jnp.arange(n_chunks), chunked(q_lat), chunked(q_idx), chunked(w_idx)))
    o_lat = o_lat.swapaxes(0, 1).reshape(B, S, DSA_HEADS, DSA_KV_RANK)
    o = jnp.einsum('bshc,chd->bshd', o_lat, w_uv)
    return o.reshape(B, S, DSA_WIDTH)


def moba_attention(q, k, v):
    B, S, H, Dh = q.shape
    nb = -(-S // MOBA_BLOCK)
    pad = nb * MOBA_BLOCK - S
    kp = jnp.pad(k, ((0, 0), (0, pad), (0, 0), (0, 0)))
    vp = jnp.pad(v, ((0, 0), (0, pad), (0, 0), (0, 0)))
    kb = kp.reshape(B, nb, MOBA_BLOCK, H, Dh).transpose(0, 3, 1, 2, 4)
    vb = vp.reshape(B, nb, MOBA_BLOCK, H, Dh).transpose(0, 3, 1, 2, 4)
    k_mean = jnp.mean(kb, axis=3)
    n_top = min(MOBA_TOPK, nb - 1)
    qc = min(MOBA_Q_CHUNK, S)
    n_chunks = S // qc
    slopes = alibi_slopes(MOBA_HEADS)
    scale = Dh ** -0.5
    blk_ids = jnp.arange(nb)
    off = jnp.arange(MOBA_BLOCK)
    gather = jax.vmap(jax.vmap(lambda blocks, ii: blocks[ii]))

    def step(args):
        ci, qq = args
        t = ci * qc + jnp.arange(qc)
        blk = (ci * qc) // MOBA_BLOCK
        k_own = lax.dynamic_slice_in_dim(kp, blk * MOBA_BLOCK, MOBA_BLOCK, axis=1)
        v_own = lax.dynamic_slice_in_dim(vp, blk * MOBA_BLOCK, MOBA_BLOCK, axis=1)
        s_own = jnp.einsum('bqhd,bkhd->bqhk', qq, k_own).astype(jnp.float32) * scale
        d_own = (t[:, None] - (blk * MOBA_BLOCK + off)[None, :]).astype(jnp.float32)
        s_own = s_own - slopes[None, None, :, None] * d_own[None, :, None, :]
        s_own = jnp.where((d_own >= 0)[None, :, None, :], s_own, -jnp.inf)
        if n_top == 0:
            p_own = jax.nn.softmax(s_own, axis=-1).astype(v.dtype)
            return jnp.einsum('bqhk,bkhd->bqhd', p_own, v_own)
        gate = jnp.einsum('bqhd,bhnd->bqhn', qq, k_mean).astype(jnp.float32)
        gate = jnp.where(blk_ids < blk, gate, -jnp.inf)
        _, sel = lax.top_k(gate, n_top)
        sel_h = sel.transpose(0, 2, 1, 3)
        k_sel = gather(kb, sel_h)
        v_sel = gather(vb, sel_h)
        s_past = jnp.einsum('bqhd,bhqjkd->bqhjk', qq, k_sel).astype(jnp.float32) * scale
        d_past = (t[None, :, None, None, None] - (sel[..., None] * MOBA_BLOCK + off)).astype(jnp.float32)
        s_past = s_past - slopes[None, None, :, None, None] * d_past
        s_past = jnp.where((sel < blk)[..., None], s_past, -jnp.inf)
        n_past = n_top * MOBA_BLOCK
        s_all = jnp.concatenate([s_past.reshape(B, qc, H, n_past), s_own], axis=-1)
        p = jax.nn.softmax(s_all, axis=-1).astype(v.dtype)
        p_past = p[..., :n_past].reshape(B, qc, H, n_top, MOBA_BLOCK)
        p_own = p[..., n_past:]
        return (jnp.einsum('bqhjk,bhqjkd->bqhd', p_past, v_sel)
                + jnp.einsum('bqhk,bkhd->bqhd', p_own, v_own))

    qs = q.reshape(B, n_chunks, qc, H, Dh).swapaxes(0, 1)
    o = lax.map(step, (jnp.arange(n_chunks), qs))
    return o.swapaxes(0, 1).reshape(B, S, H * Dh)


def setup_inputs(seed: int = 0) -> dict:
    key = jax.random.key(seed)
    ks = jax.random.split(key, 32)

    def nrm(k, shape, scale):
        return jax.random.normal(k, shape, jnp.float32) * scale

    def gain(k, shape):
        return 1.0 + 0.02 * jax.random.normal(k, shape, jnp.float32)

    L = DEPTH
    return {
        "x": nrm(ks[0], (BATCH, SEQ, D_MODEL), 1.0),
        "c": nrm(ks[1], (BATCH, D_MODEL), 1.0),
        "w_ada": nrm(ks[2], (L, D_MODEL, N_MOD * D_MODEL), 0.1 * D_MODEL ** -0.5),
        "b_ada": nrm(ks[3], (L, N_MOD * D_MODEL), 0.01),
        "g_ffn1": gain(ks[4], (L, D_MODEL)),
        "w1_ffn1": nrm(ks[5], (L, D_MODEL, D_FF), D_MODEL ** -0.5),
        "w3_ffn1": nrm(ks[6], (L, D_MODEL, D_FF), D_MODEL ** -0.5),
        "w2_ffn1": nrm(ks[7], (L, D_FF, D_MODEL), D_FF ** -0.5),
        "g_mix": gain(ks[8], (L, D_MODEL)),
        "w_in": nrm(ks[9], (L, D_MODEL, IN_WIDTH), D_MODEL ** -0.5),
        "g_cq": gain(ks[10], (L, DSA_Q_RANK)),
        "g_ckv": gain(ks[11], (L, DSA_KV_RANK)),
        "g_kidx": gain(ks[12], (L, IDX_DIM)),
        "b_kidx": nrm(ks[13], (L, IDX_DIM), 0.01),
        "w_uq": nrm(ks[14], (L, DSA_Q_RANK, DSA_HEADS, HEAD_DIM), DSA_Q_RANK ** -0.5),
        "w_qidx": nrm(ks[15], (L, DSA_Q_RANK, IDX_HEADS, IDX_DIM), DSA_Q_RANK ** -0.5),
        "w_uk": nrm(ks[16], (L, DSA_KV_RANK, DSA_HEADS, HEAD_DIM), DSA_KV_RANK ** -0.5),
        "w_uv": nrm(ks[17], (L, DSA_KV_RANK, DSA_HEADS, HEAD_DIM), DSA_KV_RANK ** -0.5),
        "w_proj_dsa": nrm(ks[18], (L, DSA_WIDTH, D_MODEL), DSA_WIDTH ** -0.5),
        "w_proj_moba": nrm(ks[19], (L, MOBA_WIDTH, D_MODEL), MOBA_WIDTH ** -0.5),
        "w_out": nrm(ks[20], (L, D_MODEL, D_MODEL), D_MODEL ** -0.5),
        "g_ffn2": gain(ks[21], (L, D_MODEL)),
        "w1_ffn2": nrm(ks[22], (L, D_MODEL, D_FF), D_MODEL ** -0.5),
        "w3_ffn2": nrm(ks[23], (L, D_MODEL, D_FF), D_MODEL ** -0.5),
        "w2_ffn2": nrm(ks[24], (L, D_FF, D_MODEL), D_FF ** -0.5),
        "g_final": gain(ks[25], (D_MODEL,)),
    }


def reference(x, c, w_ada, b_ada, g_ffn1, w1_ffn1, w3_ffn1, w2_ffn1, g_mix, w_in,
              g_cq, g_ckv, g_kidx, b_kidx, w_uq, w_qidx, w_uk, w_uv,
              w_proj_dsa, w_proj_moba, w_out, g_ffn2, w1_ffn2, w3_ffn2, w2_ffn2, g_final):
    B, S, _ = x.shape
    c_act = jax.nn.silu(c)
    for i in range(DEPTH):
        mods = c_act @ w_ada[i] + b_ada[i]
        sh1, sc1, gt1, sh2, sc2, gt2, sh3, sc3, gt3 = jnp.split(mods, N_MOD, axis=-1)

        h = modulate(rms_norm(x, g_ffn1[i]), sh1, sc1)
        x = x + 0.5 * (1.0 + gt1[:, None, :]) * swiglu(h, w1_ffn1[i], w3_ffn1[i], w2_ffn1[i])

        h = modulate(rms_norm(x, g_mix[i]), sh2, sc2)
        cq, ckv, kidx, widx, mq, mk, mv, ga, gb = split_cols(h @ w_in[i])
        cq = rms_norm(cq, g_cq[i])
        ckv = rms_norm(ckv, g_ckv[i])
        kidx = layer_norm(kidx, g_kidx[i], b_kidx[i])
        y_dsa = dsa_attention(cq, ckv, kidx, widx, w_uq[i], w_qidx[i], w_uk[i], w_uv[i]) @ w_proj_dsa[i]
        shp = (B, S, MOBA_HEADS, HEAD_DIM)
        y_moba = moba_attention(mq.reshape(shp), mk.reshape(shp), mv.reshape(shp)) @ w_proj_moba[i]
        y = jax.nn.sigmoid(ga) * y_dsa + jax.nn.sigmoid(gb) * y_moba
        x = x + (1.0 + gt2[:, None, :]) * (y @ w_out[i])

        h = modulate(rms_norm(x, g_ffn2[i]), sh3, sc3)
        x = x + 0.5 * (1.0 + gt3[:, None, :]) * swiglu(h, w1_ffn2[i], w3_ffn2[i], w2_ffn2[i])
    return rms_norm(x, g_final)
```

```cpp
#include <hip/hip_runtime.h>
#include <cstdio>
#include <cstdint>
namespace pg8 {
#define PG8_LAS __attribute__((address_space(3)))
typedef unsigned short bf16_t;
typedef short bf16x8 __attribute__((ext_vector_type(8)));
typedef float f32x4 __attribute__((ext_vector_type(4)));
typedef unsigned u32x4 __attribute__((ext_vector_type(4)));
constexpr int BM = 256, BK = 64, HALF = 128, HTB = HALF * BK * 2  , STAGE_BYTES = 8 * HTB, NXCD = 8, WGM = 8;

__host__ __device__ __forceinline__ int lds_byte(int r, int c) { const int st = (r >> 4) * 2 + (c >> 5), rr = r & 15, cc = c & 31, ob = rr * 64 + cc * 2; return st * 1024 + (ob ^ (((ob >> 9) & 1) << 5)); }
__host__ __device__ __forceinline__ void stage_rc(int b, int& R, int& C) { const int st = b / 1024, sb = b % 1024, swz = sb ^ (((sb >> 9) & 1) << 5); R = (st >> 1) * 16 + swz / 64; C = (st & 1) * 32 + (swz % 64) / 2; }
__host__ __device__ __forceinline__ int perm32(int rho) { const int n = rho >> 4, i = rho & 15; return 8 * (i >> 2) + 4 * n + (i & 3); }

struct Unit { int pm, pn; };
struct Gemm { const bf16_t* A; const bf16_t* Bt; int M, N, K; };

struct StaticOrder {
    int nM, nN, nwg, G, c;
    __host__ __device__ void init(int M, int N, int G_, int c_) { nM = M / BM; nN = N / BM; nwg = nM * nN; G = G_; c = c_; }
    __host__ __device__ bool next(int i, Unit& u) const {
        const long L = (long)i * G + c; if (L >= nwg) return false;
        int wgid = (int)L; { const int q = nwg / NXCD, r = nwg % NXCD, xcd = wgid % NXCD, off = wgid / NXCD; wgid = (xcd < r ? xcd * (q + 1) : r * (q + 1) + (xcd - r) * q) + off; }
        const int nig = WGM * nN, gid = wgid / nig, fm = gid * WGM, gsz = (nM - fm) < WGM ? (nM - fm) : WGM;
        u.pm = fm + ((wgid % nig) % gsz); u.pn = (wgid % nig) / gsz; return true;
    }
    __device__ __forceinline__ void a_ready(const Unit&) const {}
    __device__ __forceinline__ void done(const Unit&) const {}
};

__device__ __forceinline__ unsigned cvt_pk_bf16(float lo, float hi) { unsigned r; asm volatile("v_cvt_pk_bf16_f32 %0, %1, %2" : "=v"(r) : "v"(lo), "v"(hi)); return r; }
typedef unsigned u32x2 __attribute__((ext_vector_type(2)));
__device__ __forceinline__ float bflo(unsigned w) { return __uint_as_float(w << 16); }
__device__ __forceinline__ float bfhi(unsigned w) { return __uint_as_float(w & 0xffff0000u); }
__device__ __forceinline__ float fast_sigmoid(float x) { return __builtin_amdgcn_rcpf(1.0f + __builtin_amdgcn_exp2f(-1.4426950408889634f * x)); }

struct EpiSwiglu {
    static constexpr bool PERM = true, AFTER_DRAIN = false;
    bf16_t* O; int ldc;
    __device__ __forceinline__ void operator()(const f32x4 (&acc)[2][2][4][2], const Unit& u, int wr, int wc, int fr, int fq) const {
        const int row0 = u.pm * BM + wr * 64 + fr, col0 = u.pn * HALF + wc * 32 + 8 * fq;
#pragma unroll
        for (int ai = 0; ai < 2; ++ai)
#pragma unroll
            for (int m = 0; m < 4; ++m) {
                bf16_t* rowp = O + (size_t)(row0 + ai * HALF + m * 16) * ldc + col0;
                float o[8];
#pragma unroll
                for (int n = 0; n < 2; ++n)
#pragma unroll
                    for (int j = 0; j < 4; ++j) { const float a = acc[ai][0][m][n][j], g = acc[ai][1][m][n][j]; o[4 * n + j] = a * fast_sigmoid(a) * g; }
                u32x4 w; w.x = cvt_pk_bf16(o[0], o[1]); w.y = cvt_pk_bf16(o[2], o[3]); w.z = cvt_pk_bf16(o[4], o[5]); w.w = cvt_pk_bf16(o[6], o[7]);
                *(u32x4*)rowp = w;
            }
    }
};
struct EpiResid {
    static constexpr bool PERM = false, AFTER_DRAIN = false;
    const float* base; float* out; int ldc; const float* gate; int gstride; float coef;
    __device__ __forceinline__ void operator()(const f32x4 (&acc)[2][2][4][2], const Unit& u, int wr, int wc, int fr, int fq) const {
        const float* gp = gate + (size_t)(u.pm >> 3) * gstride;
        const int col0 = u.pn * BM + wc * 32 + 4 * fq;
#pragma unroll
        for (int bj = 0; bj < 2; ++bj)
#pragma unroll
            for (int n = 0; n < 2; ++n) {
                const f32x4 gv = *(const f32x4*)(gp + col0 + bj * HALF + n * 16);
                const f32x4 s = (gv + 1.0f) * coef;
#pragma unroll
                for (int ai = 0; ai < 2; ++ai)
#pragma unroll
                    for (int m = 0; m < 4; ++m) {
                        const size_t off = (size_t)(u.pm * BM + ai * HALF + wr * 64 + m * 16 + fr) * ldc + col0 + bj * HALF + n * 16;
                        const f32x4 bs = *(const f32x4*)(base + off);
                        *(f32x4*)(out + off) = bs + s * acc[ai][bj][m][n];
                    }
            }
    }
};
struct EpiStore2 {
    static constexpr bool PERM = true, AFTER_DRAIN = false;
    bf16_t* O0; int ld0; int split_pn; bf16_t* O1; int ld1;
    __device__ __forceinline__ void operator()(const f32x4 (&acc)[2][2][4][2], const Unit& u, int wr, int wc, int fr, int fq) const {
        const bool first = u.pn < split_pn;
        bf16_t* base = first ? O0 : O1; const int ld = first ? ld0 : ld1; const int colt = (first ? u.pn : u.pn - split_pn) * BM;
        const int row0 = u.pm * BM + wr * 64 + fr, col0 = colt + wc * 32 + 8 * fq;
#pragma unroll
        for (int ai = 0; ai < 2; ++ai)
#pragma unroll
            for (int m = 0; m < 4; ++m) {
                bf16_t* rowp = base + (size_t)(row0 + ai * HALF + m * 16) * ld + col0;
#pragma unroll
                for (int bj = 0; bj < 2; ++bj) {
                    const f32x4 v0 = acc[ai][bj][m][0], v1 = acc[ai][bj][m][1];
                    u32x4 w; w.x = cvt_pk_bf16(v0[0], v0[1]); w.y = cvt_pk_bf16(v0[2], v0[3]); w.z = cvt_pk_bf16(v1[0], v1[1]); w.w = cvt_pk_bf16(v1[2], v1[3]);
                    *(u32x4*)(rowp + bj * HALF) = w;
                }
            }
    }
};
template <bool HAS_ADD> struct EpiGate {
    static constexpr bool PERM = true, AFTER_DRAIN = false;
    bf16_t* O; const bf16_t* add; int ldc; const bf16_t* G; int ldg;
    __device__ __forceinline__ void operator()(const f32x4 (&acc)[2][2][4][2], const Unit& u, int wr, int wc, int fr, int fq) const {
        const int row0 = u.pm * BM + wr * 64 + fr, col0 = u.pn * BM + wc * 32 + 8 * fq;
#pragma unroll
        for (int ai = 0; ai < 2; ++ai)
#pragma unroll
            for (int m = 0; m < 4; ++m) {
                const size_t row = (size_t)(row0 + ai * HALF + m * 16);
#pragma unroll
                for (int bj = 0; bj < 2; ++bj) {
                    const u32x4 gw = *(const u32x4*)(G + row * ldg + col0 + bj * HALF);
                    u32x4 aw = (u32x4){0u, 0u, 0u, 0u};
                    if (HAS_ADD) aw = *(const u32x4*)(add + row * ldc + col0 + bj * HALF);
                    const f32x4 v0 = acc[ai][bj][m][0], v1 = acc[ai][bj][m][1];
                    float o[8];
                    o[0] = bflo(aw.x) + fast_sigmoid(bflo(gw.x)) * v0[0]; o[1] = bfhi(aw.x) + fast_sigmoid(bfhi(gw.x)) * v0[1];
                    o[2] = bflo(aw.y) + fast_sigmoid(bflo(gw.y)) * v0[2]; o[3] = bfhi(aw.y) + fast_sigmoid(bfhi(gw.y)) * v0[3];
                    o[4] = bflo(aw.z) + fast_sigmoid(bflo(gw.z)) * v1[0]; o[5] = bfhi(aw.z) + fast_sigmoid(bfhi(gw.z)) * v1[1];
                    o[6] = bflo(aw.w) + fast_sigmoid(bflo(gw.w)) * v1[2]; o[7] = bfhi(aw.w) + fast_sigmoid(bfhi(gw.w)) * v1[3];
                    u32x4 w; w.x = cvt_pk_bf16(o[0], o[1]); w.y = cvt_pk_bf16(o[2], o[3]); w.z = cvt_pk_bf16(o[4], o[5]); w.w = cvt_pk_bf16(o[6], o[7]);
                    *(u32x4*)(O + row * ldc + col0 + bj * HALF) = w;
                }
            }
    }
};

template <class Epi, class Sched, bool ALIGN_EPI = false, bool SP2 = false>
__device__ __forceinline__ void gemm_phase(PG8_LAS unsigned char* lds, const Gemm g, const Sched& S, const Epi& E) {
    const int tid = threadIdx.x, wid = __builtin_amdgcn_readfirstlane(tid >> 6), lane = tid & 63, wr = wid >> 2, wc = wid & 3, fr = lane & 15, fq = lane >> 4;
    const int K = g.K, nt = K / BK;
    unsigned voffA[2], voffB[2];
#pragma unroll
    for (int i = 0; i < 2; ++i) { int R, C; stage_rc(tid * 16 + i * 8192, R, C); const int Rb = Epi::PERM ? ((R & ~31) + perm32(R & 31)) : R;
        voffA[i] = (unsigned)(R * K + C) * 2u; voffB[i] = (unsigned)(Rb * K + C) * 2u; }
    const size_t kstep = (size_t)(BK * 2);
    const size_t hstep = (size_t)HALF * K * 2;
    const size_t tstep = 2 * hstep;
    const unsigned ldsw = (unsigned)wid * 1024u;
    const int aoff = lds_byte(wr * 64 + fr, fq * 8), boff = lds_byte(wc * 32 + fr, fq * 8);
#define PG8_SA(b, h) (((b) * 2 + (h)) * HTB)
#define PG8_SB(b, h) ((4 + (b) * 2 + (h)) * HTB)
#define PG8_STAGE(bufoff, gbase, voff) do { _Pragma("unroll") for (int _i = 0; _i < 2; ++_i) \
        __builtin_amdgcn_global_load_lds((const unsigned*)((const char*)(gbase) + (voff)[_i]), (PG8_LAS unsigned*)(lds + (bufoff) + ldsw + _i * 8192), 16, 0, 0); } while (0)
#define PG8_LDA(dst, b, h) do { _Pragma("unroll") for (int m = 0; m < 4; ++m) _Pragma("unroll") for (int k = 0; k < 2; ++k) dst[m][k] = *(const PG8_LAS bf16x8*)(lds + PG8_SA(b, h) + aoff + m * 2048 + k * 1024); } while (0)
#define PG8_LDB(dst, b, h) do { _Pragma("unroll") for (int n = 0; n < 2; ++n) _Pragma("unroll") for (int k = 0; k < 2; ++k) dst[n][k] = *(const PG8_LAS bf16x8*)(lds + PG8_SB(b, h) + boff + n * 2048 + k * 1024); } while (0)
#define PG8_MMA(ai, bj, At, Bt) do { __builtin_amdgcn_s_setprio(1); _Pragma("unroll") for (int m = 0; m < 4; ++m) _Pragma("unroll") for (int n = 0; n < 2; ++n) _Pragma("unroll") for (int k = 0; k < 2; ++k) \
        acc[ai][bj][m][n] = __builtin_amdgcn_mfma_f32_16x16x32_bf16(Bt[n][k], At[m][k], acc[ai][bj][m][n], 0, 0, 0); __builtin_amdgcn_s_setprio(0); } while (0)
#define PG8_WAIT_V(n) asm volatile("s_waitcnt vmcnt(" #n ")" ::: "memory")
#define PG8_WAIT_L(n) asm volatile("s_waitcnt lgkmcnt(" #n ")" ::: "memory")
#define PG8_BAR __builtin_amdgcn_s_barrier()
#define PG8_SCHED __builtin_amdgcn_sched_barrier(0)
    Unit cur, nxt; int ui = 0;
    if (!S.next(0, cur)) return;
    f32x4 acc[2][2][4][2];
#pragma unroll
    for (int a = 0; a < 2; ++a)
#pragma unroll
        for (int b = 0; b < 2; ++b)
#pragma unroll
            for (int m = 0; m < 4; ++m)
#pragma unroll
                for (int n = 0; n < 2; ++n) acc[a][b][m][n] = (f32x4){0.f, 0.f, 0.f, 0.f};
    bf16x8 At[4][2], B0[2][2], B1[2][2];
    const char* cA = (const char*)g.A + (size_t)cur.pm * tstep; const char* cB = (const char*)g.Bt + (size_t)cur.pn * tstep;
    S.a_ready(cur);
    if constexpr (SP2) {
        PG8_STAGE(PG8_SB(0, 0), cB, voffB); PG8_STAGE(PG8_SB(0, 1), cB + hstep, voffB); PG8_STAGE(PG8_SA(0, 0), cA, voffA); PG8_STAGE(PG8_SA(0, 1), cA + hstep, voffA);
        if (wr == 1) PG8_BAR;
        PG8_WAIT_V(2); PG8_BAR;
        PG8_STAGE(PG8_SB(1, 0), cB + kstep, voffB); PG8_STAGE(PG8_SA(1, 0), cA + kstep, voffA); PG8_STAGE(PG8_SB(1, 1), cB + hstep + kstep, voffB);
        PG8_WAIT_V(6); PG8_BAR;
    } else {
        PG8_STAGE(PG8_SB(0, 0), cB, voffB); PG8_STAGE(PG8_SA(0, 0), cA, voffA); PG8_STAGE(PG8_SB(0, 1), cB + hstep, voffB); PG8_STAGE(PG8_SA(0, 1), cA + hstep, voffA);
        if (wr == 1) PG8_BAR;
        PG8_WAIT_V(4); PG8_BAR;
        PG8_STAGE(PG8_SB(1, 0), cB + kstep, voffB); PG8_STAGE(PG8_SA(1, 0), cA + kstep, voffA); PG8_STAGE(PG8_SB(1, 1), cB + hstep + kstep, voffB);
        PG8_WAIT_V(6); PG8_BAR;
    }
    for (;;) {
        const bool has_next = S.next(ui + 1, nxt);
        const char* nA = has_next ? (const char*)g.A + (size_t)nxt.pm * tstep : cA; const char* nB = has_next ? (const char*)g.Bt + (size_t)nxt.pn * tstep : cB;
        for (int t = 0; t < nt; t += 2) {
            const bool last = (t == nt - 2);
            const char* a1 = cA + (size_t)(t + 1) * kstep;
            const char* a2 = last ? nA : cA + (size_t)(t + 2) * kstep; const char* b2 = last ? nB : cB + (size_t)(t + 2) * kstep;
            const char* a3 = a2 + kstep; const char* b3 = b2 + kstep;
            if (last && has_next) S.a_ready(nxt);
            if constexpr (SP2) {
            PG8_LDB(B0, 0, 0); PG8_LDB(B1, 0, 1); PG8_SCHED; PG8_LDA(At, 0, 0); PG8_STAGE(PG8_SA(1, 1), a1 + hstep, voffA);
            PG8_WAIT_V(8); PG8_WAIT_L(0); PG8_BAR; PG8_MMA(0, 0, At, B0); PG8_MMA(0, 1, At, B1); PG8_BAR; PG8_SCHED;
            PG8_LDA(At, 0, 1); PG8_STAGE(PG8_SB(0, 0), b2, voffB); PG8_STAGE(PG8_SB(0, 1), b2 + hstep, voffB); PG8_STAGE(PG8_SA(0, 0), a2, voffA);
            PG8_WAIT_V(8); PG8_WAIT_L(0); PG8_BAR; PG8_MMA(1, 0, At, B0); PG8_MMA(1, 1, At, B1); PG8_BAR; PG8_SCHED;
            PG8_LDB(B0, 1, 0); PG8_LDB(B1, 1, 1); PG8_SCHED; PG8_LDA(At, 1, 0); PG8_STAGE(PG8_SA(0, 1), a2 + hstep, voffA);
            PG8_WAIT_V(8); PG8_WAIT_L(0); PG8_BAR; PG8_MMA(0, 0, At, B0); PG8_MMA(0, 1, At, B1); PG8_BAR; PG8_SCHED;
            PG8_LDA(At, 1, 1); PG8_STAGE(PG8_SB(1, 0), b3, voffB); PG8_STAGE(PG8_SB(1, 1), b3 + hstep, voffB); PG8_STAGE(PG8_SA(1, 0), a3, voffA);
            PG8_WAIT_V(8); PG8_WAIT_L(0); PG8_BAR; PG8_MMA(1, 0, At, B0); PG8_MMA(1, 1, At, B1); PG8_BAR; PG8_SCHED;
            } else {
            PG8_LDB(B0, 0, 0); PG8_SCHED; PG8_LDA(At, 0, 0); PG8_STAGE(PG8_SA(1, 1), a1 + hstep, voffA);
            PG8_WAIT_L(8); PG8_BAR; PG8_WAIT_L(0); PG8_MMA(0, 0, At, B0); PG8_BAR; PG8_SCHED;
            PG8_LDB(B1, 0, 1); PG8_STAGE(PG8_SB(0, 0), b2, voffB);
            PG8_BAR; PG8_WAIT_L(0); PG8_MMA(0, 1, At, B1); PG8_BAR;
            PG8_LDA(At, 0, 1); PG8_STAGE(PG8_SA(0, 0), a2, voffA);
            PG8_BAR; PG8_WAIT_L(0); PG8_MMA(1, 0, At, B0); PG8_BAR; PG8_SCHED;
            PG8_STAGE(PG8_SB(0, 1), b2 + hstep, voffB);
            PG8_WAIT_V(6); PG8_BAR; PG8_MMA(1, 1, At, B1); PG8_BAR;
            PG8_LDB(B0, 1, 0); PG8_SCHED; PG8_LDA(At, 1, 0); PG8_STAGE(PG8_SA(0, 1), a2 + hstep, voffA);
            PG8_WAIT_L(8); PG8_BAR; PG8_WAIT_L(0); PG8_MMA(0, 0, At, B0); PG8_BAR; PG8_SCHED;
            PG8_LDB(B1, 1, 1); PG8_STAGE(PG8_SB(1, 0), b3, voffB);
            PG8_BAR; PG8_WAIT_L(0); PG8_MMA(0, 1, At, B1); PG8_BAR;
            PG8_LDA(At, 1, 1); PG8_STAGE(PG8_SA(1, 0), a3, voffA);
            PG8_BAR; PG8_WAIT_L(0); PG8_MMA(1, 0, At, B0); PG8_BAR; PG8_SCHED;
            PG8_STAGE(PG8_SB(1, 1), b3 + hstep, voffB);
            PG8_WAIT_V(6); PG8_BAR; PG8_MMA(1, 1, At, B1); PG8_BAR;
            }
        }
        if constexpr (ALIGN_EPI) { if (wr == 0) PG8_BAR; }
        if constexpr (!Epi::AFTER_DRAIN) { E(acc, cur, wr, wc, fr, fq); S.done(cur); }
        if (!has_next) break;
#pragma unroll
        for (int a = 0; a < 2; ++a)
#pragma unroll
            for (int b = 0; b < 2; ++b)
#pragma unroll
                for (int m = 0; m < 4; ++m)
#pragma unroll
                    for (int n = 0; n < 2; ++n) acc[a][b][m][n] = (f32x4){0.f, 0.f, 0.f, 0.f};
        cur = nxt; cA = nA; cB = nB; ++ui;
        if constexpr (ALIGN_EPI) { if (wr == 1) PG8_BAR; }
    }
    PG8_WAIT_V(0);
    if constexpr (!ALIGN_EPI) { if (wr == 0) PG8_BAR; }
    PG8_BAR;
    if constexpr (Epi::AFTER_DRAIN) { E.fused(acc, cur, wr, wc, fr, fq, lds, wid, lane); S.done(cur); }
#undef PG8_SA
#undef PG8_SB
#undef PG8_STAGE
#undef PG8_LDA
#undef PG8_LDB
#undef PG8_MMA
#undef PG8_WAIT_V
#undef PG8_WAIT_L
#undef PG8_BAR
#undef PG8_SCHED
}
}

constexpr int NWAVES = 8;
constexpr int BATCH = 32, SEQ = 2048, D = 1024, FF = 2816, M = BATCH * SEQ;
constexpr int NMOD = 9, MODW = NMOD * D;
constexpr int INW = 4036, PW = 4096;
constexpr int PC_CQ = 0, PC_CKV = 256, PC_KIDX = 384, PC_WIDX = 448, PC_MQ = 512, PC_MK = 1024, PC_MV = 1536, PC_GA = 2048, PC_GB = 3072;
constexpr float EPS = 1e-6f, LOG2E = 1.4426950408889634f;
constexpr int NPHASE = 16;
#ifndef MK_ONE_LAUNCH
#define MK_ONE_LAUNCH 0
#endif

constexpr size_t MiB = 1u << 20;
constexpr size_t WS_CTL = 0, CTL_ZERO_BYTES = 1 * MiB;
constexpr size_t WS_MODS = 1 * MiB;
constexpr size_t WS_WT1A = 4 * MiB, WS_W2TA = 15 * MiB, WS_WT1B = 21 * MiB, WS_W2TB = 32 * MiB, WS_WIN = 38 * MiB, WS_WQ = 46 * MiB, WS_WC = 47 * MiB, WS_WPM = 49 * MiB, WS_WOUT = 50 * MiB;
constexpr size_t WS_CQN = 52 * MiB, WS_CKVN = 84 * MiB, WS_KIDXN = 100 * MiB, WS_WIDX = 108 * MiB, WS_QIDX = 110 * MiB, WS_OMOBA = 142 * MiB;
constexpr size_t WS_XN = 206 * MiB;
constexpr size_t WS_OLAT = 334 * MiB;
constexpr size_t WS_P = 462 * MiB;
constexpr size_t WS_END = 974 * MiB;
constexpr int CW_BAR = 4096;

constexpr int LDSCTL_OFF = 140288, MISC_OFF = LDSCTL_OFF + 320;
constexpr int LDS_BYTES = 147456;
static_assert(MISC_OFF + 128 <= LDS_BYTES, "LDS map");

#define GAS __attribute__((address_space(1)))
#define LAS __attribute__((address_space(3)))
typedef unsigned short bf16;
typedef unsigned v4u __attribute__((ext_vector_type(4)));
typedef unsigned v2u __attribute__((ext_vector_type(2)));
typedef float f32x4 __attribute__((ext_vector_type(4)));
typedef float f32x16 __attribute__((ext_vector_type(16)));
typedef short bf16x8 __attribute__((ext_vector_type(8)));
typedef short s16x4 __attribute__((ext_vector_type(4)));
typedef short v4i16_t __attribute__((ext_vector_type(4)));
typedef GAS unsigned gu32;
#define RLX_AGENT __ATOMIC_RELAXED, __HIP_MEMORY_SCOPE_AGENT
#define LDS_WAIT() asm volatile("s_waitcnt lgkmcnt(0)" ::: "memory")
__device__ __forceinline__ unsigned f2bf(float f) { unsigned u = __builtin_bit_cast(unsigned, f); return (u + 0x7fffu + ((u >> 16) & 1u)) >> 16; }
__device__ __forceinline__ unsigned pk2(float lo, float hi) { return f2bf(lo) | (f2bf(hi) << 16); }
__device__ __forceinline__ float bf2f(bf16 v) { return __uint_as_float((unsigned)v << 16); }
__device__ __forceinline__ float wlo(unsigned w) { return __uint_as_float(w << 16); }
__device__ __forceinline__ float whi(unsigned w) { return __uint_as_float(w & 0xffff0000u); }
typedef float f32x2_t __attribute__((ext_vector_type(2))); typedef __bf16 bf16x2_t __attribute__((ext_vector_type(2)));
__device__ __forceinline__ unsigned cvtpk(float lo, float hi) { f32x2_t v = {lo, hi}; bf16x2_t b = __builtin_convertvector(v, bf16x2_t); return __builtin_bit_cast(unsigned, b); }
__device__ __forceinline__ float wave_sum(float v) {
#pragma unroll
    for (int o = 1; o < 64; o <<= 1) v += __shfl_xor(v, o);
    return v;
}

#define XB_TMO      128
#define XB_XCNT(j)  (256  + 64 * (j))
#define XB_XSUB(j)  (1280 + 64 * (j))
#define XB_XGEN(j)  (2304 + 64 * (j))
#define XB_TOP      3328
#define XB_TOPGEN   3392
#define XCD_BAR_WORDS 3456
#define XB_SPIN_CAP (1u << 18)

__device__ __forceinline__ unsigned xb_ld(unsigned* p)              { return __hip_atomic_load(p, __ATOMIC_RELAXED, __HIP_MEMORY_SCOPE_AGENT); }
__device__ __forceinline__ unsigned xb_add(unsigned* p, unsigned v) { return __hip_atomic_fetch_add(p, v, __ATOMIC_RELAXED, __HIP_MEMORY_SCOPE_AGENT); }
__device__ __forceinline__ unsigned xb_xcc_id() { return (unsigned)__builtin_amdgcn_s_getreg((3 << 11) | 20) & 0xFu; }
#define XB_SPIN(cond, bar) do { unsigned _sp = 0; while (cond) { __builtin_amdgcn_s_sleep(1); \
    if ((++_sp & 255u) == 0u) { if (xb_ld(&(bar)[XB_TMO])) break; if (_sp > XB_SPIN_CAP) { atomicAdd(&(bar)[XB_TMO], 1u); break; } } } } while (0)

struct XcdBarrier {
    unsigned* bar; unsigned x;
    volatile LAS unsigned* st;
};

__device__ __forceinline__ XcdBarrier xcd_barrier_post(unsigned* bar, volatile LAS unsigned* st) {
    XcdBarrier b; b.bar = bar; b.x = xb_xcc_id(); b.st = st;
    if (threadIdx.x == 0) (void)xb_add(&bar[XB_XCNT(b.x)], 1u);
    return b;
}
__device__ __forceinline__ void xcd_barrier_complete(unsigned* bar, unsigned x, unsigned& nloc, unsigned& nx) {
    const unsigned G = gridDim.x * gridDim.y * gridDim.z;
    unsigned sum, cnt, mine, sp = 0u;
    for (;;) {
        sum = 0u; cnt = 0u; mine = 0u;
#pragma unroll
        for (unsigned j = 0; j < 16; ++j) { const unsigned c = xb_ld(&bar[XB_XCNT(j)]); sum += c; cnt += (c > 0u) ? 1u : 0u; mine = (j == x) ? c : mine; }
        if (sum == G) break;
        __builtin_amdgcn_s_sleep(1);
        if ((++sp & 255u) == 0u) { if (xb_ld(&bar[XB_TMO])) break; if (sp > XB_SPIN_CAP) { atomicAdd(&bar[XB_TMO], 1u); break; } }
    }
    nloc = mine > 0u ? mine : 1u; nx = cnt > 0u ? cnt : 1u;
}

__device__ __forceinline__ void xcd_barrier(const XcdBarrier& b) {
    asm volatile("s_waitcnt vmcnt(0)" ::: "memory");
    __syncthreads();
    if (threadIdx.x == 0) {
        unsigned* bar = b.bar;
        __builtin_amdgcn_s_waitcnt(0);
        unsigned nloc = b.st[0], nx = b.st[1];
        if (nloc == 0u) { xcd_barrier_complete(bar, b.x, nloc, nx); b.st[0] = nloc; b.st[1] = nx; }
        const unsigned old = xb_add(&bar[XB_XSUB(b.x)], 1u);
        const unsigned gen = old / nloc;
        if (old + 1u == (gen + 1u) * nloc) {
            __builtin_amdgcn_fence(__ATOMIC_RELEASE, "agent");
            asm volatile("s_waitcnt vmcnt(0)" ::: "memory");
            const unsigned og = xb_add(&bar[XB_TOP], 1u);
            const unsigned tg = og / nx;
            if (og + 1u == (tg + 1u) * nx) xb_add(&bar[XB_TOPGEN], 1u);
            else XB_SPIN(xb_ld(&bar[XB_TOPGEN]) == tg, bar);
            __builtin_amdgcn_fence(__ATOMIC_ACQUIRE, "agent");
            xb_add(&bar[XB_XGEN(b.x)], 1u);
            asm volatile("s_waitcnt vmcnt(0)" ::: "memory");
        } else {
            XB_SPIN(xb_ld(&bar[XB_XGEN(b.x)]) == gen, bar);
            __builtin_amdgcn_fence(__ATOMIC_ACQUIRE, "agent");
            asm volatile("s_waitcnt vmcnt(0)" ::: "memory");
        }
    }
    __syncthreads();
}


__device__ __forceinline__ void tr_item(const float* W, int N, int c0, int nvalid, int k0, bf16* WT, int ldk, int drow0, LAS float* scr, int lane) {
#pragma unroll 8
    for (int i = 0; i < 32; ++i) { const int kk = 2 * i + (lane >> 5), n = lane & 31; scr[kk * 33 + n] = (n < nvalid) ? W[(size_t)(k0 + kk) * N + c0 + n] : 0.f; }
    LDS_WAIT(); asm volatile("" ::: "memory");
    const int c = lane & 7;
#pragma unroll
    for (int j = 0; j < 4; ++j) { const int n = (lane >> 3) + 8 * j; const LAS float* s = scr + (8 * c) * 33 + n;
        v4u o; o.x = pk2(s[0 * 33], s[1 * 33]); o.y = pk2(s[2 * 33], s[3 * 33]); o.z = pk2(s[4 * 33], s[5 * 33]); o.w = pk2(s[6 * 33], s[7 * 33]);
        *(GAS v4u*)(WT + (size_t)(drow0 + n) * ldk + k0 + 8 * c) = o; }
    LDS_WAIT(); asm volatile("" ::: "memory");
}

__device__ __forceinline__ void normmod_phase(const float* xin, const float* g, const float* sh, const float* sc, bf16* xo, int gw, int NGW, int lane) {
    for (int row0 = gw * 32; row0 < M; row0 += NGW * 32) {
        const int b = row0 >> 11;
        f32x4 A[4], Bv[4];
#pragma unroll
        for (int j = 0; j < 4; ++j) { const int col = 4 * lane + 256 * j; const f32x4 gv = *(const f32x4*)(g + col), sv = *(const f32x4*)(sc + (size_t)b * MODW + col); A[j] = gv * (sv + 1.0f); Bv[j] = *(const f32x4*)(sh + (size_t)b * MODW + col); }
        for (int rr = 0; rr < 32; ++rr) {
            const size_t row = (size_t)(row0 + rr);
            const GAS f32x4* xr = (const GAS f32x4*)(xin + row * D) + lane;
            f32x4 v[4]; float s = 0.f;
#pragma unroll
            for (int j = 0; j < 4; ++j) { v[j] = xr[64 * j]; s += (v[j].x * v[j].x + v[j].y * v[j].y) + (v[j].z * v[j].z + v[j].w * v[j].w); }
            const float rs = 1.0f / sqrtf(wave_sum(s) * (1.0f / D) + EPS);
            GAS unsigned long long* o8 = (GAS unsigned long long*)(xo + row * D) + lane;
#pragma unroll
            for (int j = 0; j < 4; ++j) { const f32x4 o = v[j] * rs * A[j] + Bv[j]; o8[64 * j] = (unsigned long long)pk2(o.x, o.y) | ((unsigned long long)pk2(o.z, o.w) << 32); }
        }
    }
}
__device__ __forceinline__ void finalnorm_phase(const float* xin, const float* g, float* out, int gw, int NGW, int lane) {
    f32x4 A[4];
#pragma unroll
    for (int j = 0; j < 4; ++j) A[j] = *(const f32x4*)(g + 4 * lane + 256 * j);
    for (int row = gw; row < M; row += NGW) {
        const GAS f32x4* xr = (const GAS f32x4*)(xin + (size_t)row * D) + lane;
        f32x4 v[4]; float s = 0.f;
#pragma unroll
        for (int j = 0; j < 4; ++j) { v[j] = xr[64 * j]; s += (v[j].x * v[j].x + v[j].y * v[j].y) + (v[j].z * v[j].z + v[j].w * v[j].w); }
        const float rs = 1.0f / sqrtf(wave_sum(s) * (1.0f / D) + EPS);
        GAS f32x4* orow = (GAS f32x4*)(out + (size_t)row * D) + lane;
#pragma unroll
        for (int j = 0; j < 4; ++j) orow[64 * j] = v[j] * rs * A[j];
    }
}
__device__ __forceinline__ void smallnorm_phase(const bf16* P, const float* g_cq, const float* g_ckv, const float* g_kidx, const float* b_kidx,
                                                bf16* CQN, bf16* CKVN, bf16* KIDXN, float* WIDX, int gw, int NGW, int lane) {
    const f32x4 gq = *(const f32x4*)(g_cq + 4 * lane);
    const float gk0 = g_ckv[2 * lane], gk1 = g_ckv[2 * lane + 1], gi = g_kidx[lane], bi = b_kidx[lane];
    for (int row = gw; row < M; row += NGW) {
        const bf16* pr = P + (size_t)row * PW;
        const v2u wq = *(const v2u*)(pr + PC_CQ + 4 * lane);
        const unsigned wk = *(const unsigned*)(pr + PC_CKV + 2 * lane);
        const float xi = bf2f(pr[PC_KIDX + lane]);
        const float q0 = wlo(wq.x), q1 = whi(wq.x), q2 = wlo(wq.y), q3 = whi(wq.y), k0 = wlo(wk), k1 = whi(wk);
        const float rq = 1.0f / sqrtf(wave_sum((q0 * q0 + q1 * q1) + (q2 * q2 + q3 * q3)) * (1.0f / 256.0f) + EPS);
        const float rk = 1.0f / sqrtf(wave_sum(k0 * k0 + k1 * k1) * (1.0f / 128.0f) + EPS);
        const float mu = wave_sum(xi) * (1.0f / 64.0f), xc = xi - mu;
        const float ri = 1.0f / sqrtf(wave_sum(xc * xc) * (1.0f / 64.0f) + EPS);
        v2u oq; oq.x = pk2(q0 * rq * gq.x, q1 * rq * gq.y); oq.y = pk2(q2 * rq * gq.z, q3 * rq * gq.w);
        *(v2u*)(CQN + (size_t)row * 256 + 4 * lane) = oq;
        *(unsigned*)(CKVN + (size_t)row * 128 + 2 * lane) = pk2(k0 * rk * gk0, k1 * rk * gk1);
        KIDXN[(size_t)row * 64 + lane] = (bf16)f2bf(xc * ri * gi + bi);
        if (lane < 4) WIDX[(size_t)row * 4 + lane] = bf2f(pr[PC_WIDX + lane]) * 0.0625f;
    }
}

#define MFMA32(a, b, c) __builtin_amdgcn_mfma_f32_32x32x16_bf16((a), (b), (c), 0, 0, 0)
__device__ __forceinline__ s16x4 vtr(const LAS unsigned char* p) { return __builtin_bit_cast(s16x4, __builtin_amdgcn_ds_read_tr16_b64_v4i16((LAS v4i16_t*)p)); }
__device__ __forceinline__ unsigned off_b(unsigned row, unsigned ch) { return 256u * row + 16u * (ch ^ (((row & 3u) << 2) | ((row >> 2) & 3u))); }
__device__ __forceinline__ unsigned ord_key(float s) { unsigned b = __float_as_uint(s); if (b == 0x80000000u) b = 0u; return b ^ ((b >> 31) ? 0xFFFFFFFFu : 0x80000000u); }
__device__ __forceinline__ bf16x8 pack8(const f32x16& x, int s) {
    v4u w; w.x = cvtpk(x[8 * s], x[8 * s + 1]); w.y = cvtpk(x[8 * s + 2], x[8 * s + 3]); w.z = cvtpk(x[8 * s + 4], x[8 * s + 5]); w.w = cvtpk(x[8 * s + 6], x[8 * s + 7]);
    return __builtin_bit_cast(bf16x8, w);
}
constexpr int DSA_SC_OFF = 0, DSA_MASK_OFF = 131072, DSA_KT_OFF = 0;

__device__ __forceinline__ void dsa_unit(LAS unsigned char* lds, int b, int qt, const bf16* QIDX, const bf16* KIDXN, const float* WIDX, const bf16* QLAT, const bf16* CKVN, bf16* OLAT, int tid, int lane, int wave) {
    LAS float* SC = (LAS float*)(lds + DSA_SC_OFF);
    LAS unsigned* MASK = (LAS unsigned*)(lds + DSA_MASK_OFF);
    const int r = lane & 31, hh = lane >> 5;
    const size_t tokb = (size_t)b * SEQ;
    const int ntile = qt + 1;
    for (int p = 0; p < 2; ++p) {
        const int tq0 = 32 * qt + 16 * p;
        {
            bf16x8 Aq[2][4]; f32x4 wq[2][4];
#pragma unroll
            for (int rt = 0; rt < 2; ++rt) {
#pragma unroll
                for (int s = 0; s < 4; ++s) Aq[rt][s] = *(const bf16x8*)(QIDX + (tokb + tq0 + 8 * rt + (r >> 2)) * 256 + (r & 3) * 64 + 16 * s + 8 * hh);
#pragma unroll
                for (int g = 0; g < 4; ++g) wq[rt][g] = *(const f32x4*)(WIDX + (tokb + tq0 + 8 * rt + 2 * g + hh) * 4);
            }
            for (int T = wave; T < ntile; T += 8) {
                bf16x8 Bk[4];
#pragma unroll
                for (int s = 0; s < 4; ++s) Bk[s] = *(const bf16x8*)(KIDXN + (tokb + 32 * T + r) * 64 + 16 * s + 8 * hh);
#pragma unroll
                for (int rt = 0; rt < 2; ++rt) {
                    f32x16 acc;
#pragma unroll
                    for (int i = 0; i < 16; ++i) acc[i] = 0.f;
#pragma unroll
                    for (int s = 0; s < 4; ++s) acc = MFMA32(Aq[rt][s], Bk[s], acc);
#pragma unroll
                    for (int g = 0; g < 4; ++g) {
                        const float sc = (fmaxf(acc[4 * g], 0.f) * wq[rt][g][0] + fmaxf(acc[4 * g + 1], 0.f) * wq[rt][g][1]) + (fmaxf(acc[4 * g + 2], 0.f) * wq[rt][g][2] + fmaxf(acc[4 * g + 3], 0.f) * wq[rt][g][3]);
                        SC[(8 * rt + 2 * g + hh) * 2048 + 32 * T + r] = sc;
                    }
                }
            }
        }
        __syncthreads();
        for (int qi = 0; qi < 2; ++qi) {
            const int qq = wave + 8 * qi, t = tq0 + qq;
            unsigned u[32];
#pragma unroll
            for (int i = 0; i < 32; ++i) { const int key = lane + 64 * i; const float s = SC[qq * 2048 + key]; u[i] = (key <= t) ? ord_key(s) : 0u; }
            unsigned thr = 1u; bool exact = true; int need = 0;
            if (t + 1 > 256) {
                thr = 0u; exact = false;
                for (int bit = 31; bit >= 0; --bit) {
                    const unsigned cand = thr | (1u << bit);
                    int cnt = 0;
#pragma unroll
                    for (int i = 0; i < 32; ++i) cnt += __popcll(__ballot(u[i] >= cand));
                    if (cnt >= 256) { thr = cand; if (cnt == 256) { exact = true; break; } }
                }
                if (!exact) {
                    int cgt = 0;
#pragma unroll
                    for (int i = 0; i < 32; ++i) cgt += __popcll(__ballot(u[i] > thr));
                    need = 256 - cgt;
                }
            }
            unsigned long long mine = 0ull; int run = 0;
#pragma unroll
            for (int i = 0; i < 32; ++i) {
                unsigned long long sel;
                if (exact) sel = __ballot(u[i] >= thr);
                else {
                    const bool tie = (u[i] == thr); const unsigned long long tm = __ballot(tie);
                    const int below = (int)__builtin_amdgcn_mbcnt_hi((unsigned)(tm >> 32), __builtin_amdgcn_mbcnt_lo((unsigned)tm, 0u));
                    sel = __ballot((u[i] > thr) || (tie && (run + below < need)));
                    run += __popcll(tm);
                }
                if (lane == i) mine = sel;
            }
            if (lane < 32) { LAS unsigned* mp = MASK + (16 * p + qq) * 64 + 2 * lane; mp[0] = (unsigned)mine; mp[1] = (unsigned)(mine >> 32); }
        }
        __syncthreads();
    }
    {
        LAS unsigned char* KT = lds + DSA_KT_OFF;
        const int tq = 32 * qt + r; const size_t tok = tokb + tq;
        bf16x8 Qf[8];
#pragma unroll
        for (int s = 0; s < 8; ++s) Qf[s] = *(const bf16x8*)(QLAT + tok * 1024 + wave * 128 + 16 * s + 8 * hh);
        f32x16 O[4];
#pragma unroll
        for (int ct = 0; ct < 4; ++ct)
#pragma unroll
            for (int i = 0; i < 16; ++i) O[ct][i] = 0.f;
        float m = -1e30f, l = 0.f;
        const float slope2 = __builtin_amdgcn_exp2f(-(float)(wave + 1)) * LOG2E;
        const int srow = tid >> 4, sch = tid & 15;
        const unsigned soff = off_b(srow, sch);
        const unsigned xr = ((r & 3u) << 2) | ((r >> 2) & 3u);
        const int q4 = (lane & 15) >> 2, p4 = lane & 3, b16 = (lane >> 4) & 1;
        v4u stg = *(const v4u*)(CKVN + (tokb + srow) * 128 + sch * 8);
        for (int T = 0; T <= qt; ++T) {
            LAS unsigned char* kt = KT + (T & 1) * 8192;
            *(LAS v4u*)(kt + soff) = stg;
            __syncthreads();
            if (T < qt) stg = *(const v4u*)(CKVN + (tokb + 32 * (T + 1) + srow) * 128 + sch * 8);
            f32x16 pa;
#pragma unroll
            for (int i = 0; i < 16; ++i) pa[i] = 0.f;
#pragma unroll
            for (int s = 0; s < 8; ++s) { const bf16x8 a = *(const LAS bf16x8*)(kt + 256 * r + 16 * ((unsigned)(2 * s + hh) ^ xr)); pa = MFMA32(a, Qf[s], pa); }
            const unsigned mw = MASK[r * 64 + T] >> (4 * hh);
            const float fb = -slope2 * (float)(tq - 32 * T - 4 * hh);
            float tmax = -INFINITY;
#pragma unroll
            for (int i = 0; i < 16; ++i) { const int cr = (i & 3) + 8 * (i >> 2); float s2 = pa[i] + (fb + slope2 * (float)cr); s2 = ((mw >> cr) & 1u) ? s2 : -INFINITY; pa[i] = s2; tmax = fmaxf(tmax, s2); }
            tmax = fmaxf(tmax, __shfl_xor(tmax, 32));
            const float mnew = fmaxf(m, tmax), alpha = __builtin_amdgcn_exp2f(m - mnew); m = mnew;
            float ls = 0.f;
#pragma unroll
            for (int i = 0; i < 16; ++i) { const float e = __builtin_amdgcn_exp2f(pa[i] - mnew); pa[i] = e; ls += e; }
            l = l * alpha + ls;
            if (__any(alpha != 1.0f)) {
#pragma unroll
                for (int ct = 0; ct < 4; ++ct) O[ct] = O[ct] * alpha;
            }
            bf16x8 pf[2]; pf[0] = pack8(pa, 0); pf[1] = pack8(pa, 1);
#pragma unroll
            for (int ct = 0; ct < 4; ++ct)
#pragma unroll
                for (int ks = 0; ks < 2; ++ks) {
                    const s16x4 lo = vtr(kt + off_b(16 * ks + 4 * hh + q4, 4 * ct + 2 * b16 + (p4 >> 1)) + 8 * (p4 & 1));
                    const s16x4 hi = vtr(kt + off_b(16 * ks + 8 + 4 * hh + q4, 4 * ct + 2 * b16 + (p4 >> 1)) + 8 * (p4 & 1));
                    const bf16x8 vt = (bf16x8){lo[0], lo[1], lo[2], lo[3], hi[0], hi[1], hi[2], hi[3]};
                    O[ct] = MFMA32(vt, pf[ks], O[ct]);
                }
        }
        l += __shfl_xor(l, 32);
        const float inv = 1.0f / l;
        bf16* orow = OLAT + tok * 1024 + wave * 128;
#pragma unroll
        for (int ct = 0; ct < 4; ++ct)
#pragma unroll
            for (int g = 0; g < 4; ++g) {
                v2u w; w.x = cvtpk(O[ct][4 * g] * inv, O[ct][4 * g + 1] * inv); w.y = cvtpk(O[ct][4 * g + 2] * inv, O[ct][4 * g + 3] * inv);
                *(v2u*)(orow + 32 * ct + 8 * g + 4 * hh) = w;
            }
        __syncthreads();
    }
}

__device__ __forceinline__ void moba_bh(LAS unsigned char* lds, int b, int h, const bf16* P, bf16* OM, int tid, int lane, int wave) {
    LAS float* KM = (LAS float*)(lds);
    LAS float* KRED = (LAS float*)(lds + 2048);
    LAS unsigned* QS = (LAS unsigned*)(lds + 4096);
    LAS unsigned char* KTb = lds + 8192;
    LAS unsigned char* VTb = lds + 16384;
    const int r = lane & 31, hh = lane >> 5;
    const size_t tokb = (size_t)b * SEQ;
    const bf16* MQ = P + PC_MQ + h * 64; const bf16* MK = P + PC_MK + h * 64; const bf16* MV = P + PC_MV + h * 64;
    const float slope2 = __builtin_amdgcn_exp2f(-(float)(h + 1)) * LOG2E, c2 = 0.125f * LOG2E;
    const int q4 = (lane & 15) >> 2, p4 = lane & 3, b16 = (lane >> 4) & 1;
    for (int blk = 0; blk < 8; ++blk) {
        if (blk > 0) {
            const int col = tid & 63, rg = tid >> 6; float s = 0.f;
            for (int i = 0; i < 32; ++i) s += bf2f(MK[(tokb + 256 * (blk - 1) + 32 * rg + i) * PW + col]);
            KRED[rg * 64 + col] = s;
            __syncthreads();
            if (tid < 64) { float t = 0.f;
#pragma unroll
                for (int g = 0; g < 8; ++g) t += KRED[g * 64 + tid];
                KM[(blk - 1) * 64 + tid] = t * (1.0f / 256.0f); }
            __syncthreads();
        }
        if (tid < 256) {
            unsigned taken = 0u;
            if (blk > 0) {
                const bf16* qp = MQ + (tokb + 256 * blk + tid) * PW;
                float q[64];
#pragma unroll
                for (int c = 0; c < 8; ++c) { const v4u w = *(const v4u*)(qp + 8 * c); q[8 * c] = wlo(w.x); q[8 * c + 1] = whi(w.x); q[8 * c + 2] = wlo(w.y); q[8 * c + 3] = whi(w.y); q[8 * c + 4] = wlo(w.z); q[8 * c + 5] = whi(w.z); q[8 * c + 6] = wlo(w.w); q[8 * c + 7] = whi(w.w); }
                float gate[7];
#pragma unroll
                for (int n = 0; n < 7; ++n) { float a = 0.f;
#pragma unroll
                    for (int d = 0; d < 64; ++d) a += q[d] * KM[n * 64 + d];
                    gate[n] = (n < blk) ? a : -INFINITY; }
#pragma unroll
                for (int pick = 0; pick < 3; ++pick) { float bv = -INFINITY; int best = -1;
#pragma unroll
                    for (int n = 0; n < 7; ++n) { const bool ok = !((taken >> n) & 1u) && gate[n] > bv; bv = ok ? gate[n] : bv; best = ok ? n : best; }
                    if (best >= 0) taken |= 1u << best; }
            }
            QS[tid] = taken;
        }
        __syncthreads();
        const int tq = 256 * blk + 32 * wave + r; const size_t tok = tokb + tq;
        const unsigned selq = QS[32 * wave + r];
        bf16x8 Qf[4];
#pragma unroll
        for (int s = 0; s < 4; ++s) Qf[s] = *(const bf16x8*)(MQ + tok * PW + 16 * s + 8 * hh);
        f32x16 O[2];
#pragma unroll
        for (int ct = 0; ct < 2; ++ct)
#pragma unroll
            for (int i = 0; i < 16; ++i) O[ct][i] = 0.f;
        float m = -1e30f, l = 0.f;
        const int srow = (tid & 255) >> 3, sch = tid & 7;
        const bf16* ssrc = (tid < 256 ? MK : MV) + (tokb + srow) * PW + sch * 8;
        LAS unsigned char* sdst = (tid < 256 ? KTb + 128 * srow + 16 * (sch ^ (srow & 7)) : VTb + 128 * srow + 16 * sch);
        const int ntl = 8 * (blk + 1);
        v4u stg = *(const v4u*)ssrc;
        for (int gT = 0; gT < ntl; ++gT) {
            const int buf = (gT & 1) * 4096;
            *(LAS v4u*)(sdst + buf) = stg;
            __syncthreads();
            if (gT + 1 < ntl) stg = *(const v4u*)(ssrc + (size_t)32 * (gT + 1) * PW);
            const int j = gT >> 3, Tl = gT & 7;
            const bool lanesel = (j < blk) ? ((selq >> j) & 1u) : true;
            const bool active = (j < blk) ? (__any(lanesel) != 0) : (Tl <= wave);
            if (active) {
                const LAS unsigned char* kt = KTb + buf; const LAS unsigned char* vt_ = VTb + buf;
                f32x16 pa;
#pragma unroll
                for (int i = 0; i < 16; ++i) pa[i] = 0.f;
#pragma unroll
                for (int s = 0; s < 4; ++s) { const bf16x8 a = *(const LAS bf16x8*)(kt + 128 * r + 16 * ((2 * s + hh) ^ (r & 7))); pa = MFMA32(a, Qf[s], pa); }
                const float fb = -slope2 * (float)(tq - 32 * gT - 4 * hh);
                const bool diag = (j == blk) && (Tl == wave);
                float tmax = -INFINITY;
#pragma unroll
                for (int i = 0; i < 16; ++i) { const int cr = (i & 3) + 8 * (i >> 2); float s2 = pa[i] * c2 + (fb + slope2 * (float)cr);
                    const bool keep = lanesel && (!diag || (cr + 4 * hh <= r)); s2 = keep ? s2 : -INFINITY; pa[i] = s2; tmax = fmaxf(tmax, s2); }
                tmax = fmaxf(tmax, __shfl_xor(tmax, 32));
                const float mnew = fmaxf(m, tmax), alpha = __builtin_amdgcn_exp2f(m - mnew); m = mnew;
                float ls = 0.f;
#pragma unroll
                for (int i = 0; i < 16; ++i) { const float e = __builtin_amdgcn_exp2f(pa[i] - mnew); pa[i] = e; ls += e; }
                l = l * alpha + ls;
                if (__any(alpha != 1.0f)) { O[0] = O[0] * alpha; O[1] = O[1] * alpha; }
                bf16x8 pf[2]; pf[0] = pack8(pa, 0); pf[1] = pack8(pa, 1);
#pragma unroll
                for (int ct = 0; ct < 2; ++ct)
#pragma unroll
                    for (int ks = 0; ks < 2; ++ks) {
                        const s16x4 lo = vtr(vt_ + 128 * (16 * ks + 4 * hh + q4) + 16 * (4 * ct + 2 * b16 + (p4 >> 1)) + 8 * (p4 & 1));
                        const s16x4 hi = vtr(vt_ + 128 * (16 * ks + 8 + 4 * hh + q4) + 16 * (4 * ct + 2 * b16 + (p4 >> 1)) + 8 * (p4 & 1));
                        const bf16x8 vt = (bf16x8){lo[0], lo[1], lo[2], lo[3], hi[0], hi[1], hi[2], hi[3]};
                        O[ct] = MFMA32(vt, pf[ks], O[ct]);
                    }
            }
        }
        l += __shfl_xor(l, 32);
        const float inv = 1.0f / l;
        bf16* orow = OM + tok * 512 + h * 64;
#pragma unroll
        for (int ct = 0; ct < 2; ++ct)
#pragma unroll
            for (int g = 0; g < 4; ++g) {
                v2u w; w.x = cvtpk(O[ct][4 * g] * inv, O[ct][4 * g + 1] * inv); w.y = cvtpk(O[ct][4 * g + 2] * inv, O[ct][4 * g + 3] * inv);
                *(v2u*)(orow + 32 * ct + 8 * g + 4 * hh) = w;
            }
        __syncthreads();
    }
}

struct Args { const float* in[26]; float* out; unsigned char* ws; int ph_lo, ph_hi; };
__global__ void __launch_bounds__(NWAVES * 64, 2) mk_fwd(Args args) {
    extern __shared__ __attribute__((aligned(16))) unsigned char lds_raw[];
    LAS unsigned char* lds = (LAS unsigned char*)lds_raw;
    volatile LAS unsigned* MISC = (volatile LAS unsigned*)(lds + MISC_OFF);
    const int tid = threadIdx.x, lane = tid & 63, wave = __builtin_amdgcn_readfirstlane(tid >> 6);
    const int G = gridDim.x, bx = blockIdx.x;
    const int gw = bx * NWAVES + wave, NGW = G * NWAVES;
    unsigned char* ws = args.ws;
    gu32* ctl = (gu32*)(ws + WS_CTL);
    const float* x = args.in[0]; const float* cc = args.in[1]; const float* w_ada = args.in[2]; const float* b_ada = args.in[3];
    const float* g_ffn1 = args.in[4]; const float* w1a = args.in[5]; const float* w3a = args.in[6]; const float* w2a = args.in[7];
    const float* g_mix = args.in[8]; const float* w_in = args.in[9]; const float* g_cq = args.in[10]; const float* g_ckv = args.in[11];
    const float* g_kidx = args.in[12]; const float* b_kidx = args.in[13]; const float* w_uq = args.in[14]; const float* w_qidx = args.in[15];
    const float* w_uk = args.in[16]; const float* w_uv = args.in[17]; const float* w_pd = args.in[18]; const float* w_pm = args.in[19];
    const float* w_out = args.in[20]; const float* g_ffn2 = args.in[21]; const float* w1b = args.in[22]; const float* w3b = args.in[23];
    const float* w2b = args.in[24]; const float* g_final = args.in[25];
    float* out = args.out;
    float* MODS = (float*)(ws + WS_MODS);
    bf16 *WT1A = (bf16*)(ws + WS_WT1A), *W2TA = (bf16*)(ws + WS_W2TA), *WT1B = (bf16*)(ws + WS_WT1B), *W2TB = (bf16*)(ws + WS_W2TB), *WIN = (bf16*)(ws + WS_WIN), *WQ = (bf16*)(ws + WS_WQ),
         *WC = (bf16*)(ws + WS_WC), *WPM = (bf16*)(ws + WS_WPM), *WOUT = (bf16*)(ws + WS_WOUT);
    bf16 *CQN = (bf16*)(ws + WS_CQN), *CKVN = (bf16*)(ws + WS_CKVN), *KIDXN = (bf16*)(ws + WS_KIDXN), *QIDX = (bf16*)(ws + WS_QIDX), *OMOBA = (bf16*)(ws + WS_OMOBA);
    float* WIDX = (float*)(ws + WS_WIDX);
    bf16 *XN = (bf16*)(ws + WS_XN), *QLAT = XN, *T1 = XN, *OLAT = (bf16*)(ws + WS_OLAT), *Y = OLAT, *PB = (bf16*)(ws + WS_P), *U = PB;

    for (int u = tid; u < (LDS_BYTES - LDSCTL_OFF) / 4; u += NWAVES * 64) ((LAS unsigned*)(lds + LDSCTL_OFF))[u] = 0u;
    __syncthreads();
    XcdBarrier bar; bar.bar = (unsigned*)(ctl + CW_BAR); bar.x = 0; bar.st = nullptr;
    if (MK_ONE_LAUNCH) bar = xcd_barrier_post((unsigned*)(ctl + CW_BAR), MISC + 8);
    const int lo = args.ph_lo, hi = args.ph_hi;
#define IN(k) (lo <= (k) && (k) < hi)
#define SEAM(k) do { if (IN(k) && IN((k) + 1)) xcd_barrier(bar); } while (0)

    if (IN(0)) {
        LAS float* scr = (LAS float*)(lds + wave * 16384);
        int it = gw, base = 0;
#define JOB(Wp, Nsrc, col0, nvalid_, ntotal_, Kdim, WTp, ldk, rowexpr) { const int nb_ = (ntotal_) / 32, n_ = ((Kdim) / 64) * nb_; \
            for (; it < base + n_; it += NGW) { const int loc = it - base, kb = loc / nb_, n0 = (loc % nb_) * 32; const int nv = ((nvalid_) - n0) < 32 ? ((nvalid_) - n0) : 32; \
                tr_item(Wp, Nsrc, (col0) + n0, nv, kb * 64, WTp, ldk, (rowexpr), scr, lane); } base += n_; }
        JOB(w1a, FF, 0, FF, FF, D, WT1A, D, (n0 / 128) * 256 + (n0 % 128))
        JOB(w3a, FF, 0, FF, FF, D, WT1A, D, (n0 / 128) * 256 + 128 + (n0 % 128))
        JOB(w2a, D, 0, D, D, FF, W2TA, FF, n0)
        JOB(w1b, FF, 0, FF, FF, D, WT1B, D, (n0 / 128) * 256 + (n0 % 128))
        JOB(w3b, FF, 0, FF, FF, D, WT1B, D, (n0 / 128) * 256 + 128 + (n0 % 128))
        JOB(w2b, D, 0, D, D, FF, W2TB, FF, n0)
        JOB(w_in, INW, 0, 448, 448, D, WIN, D, n0)
        JOB(w_in, INW, 448, 4, 64, D, WIN, D, 448 + n0)
        JOB(w_in, INW, 452, 3584, 3584, D, WIN, D, 512 + n0)
        JOB(w_qidx, 256, 0, 256, 256, 256, WQ, 256, 1024 + n0)
        JOB(w_pm, D, 0, D, D, 512, WPM, 512, n0)
        JOB(w_out, D, 0, D, D, D, WOUT, D, n0)
#undef JOB
        for (int o = bx * 512 + tid; o < 1024 * 256; o += G * 512) {
            const int rr = o & 255, n = o >> 8, hd = n >> 7, c = n & 127;
            const float* a = w_uq + (size_t)rr * 512 + hd * 64; const float* bq = w_uk + (size_t)c * 512 + hd * 64;
            float s = 0.f;
            for (int d = 0; d < 64; ++d) s += a[d] * bq[d];
            WQ[(size_t)n * 256 + rr] = (bf16)f2bf(s * (0.125f * LOG2E));
        }
        for (int o = bx * 512 + tid; o < 1024 * 1024; o += G * 512) {
            const int k = o & 1023, n = o >> 10, hd = k >> 7, c = k & 127;
            const float* a = w_uv + (size_t)c * 512 + hd * 64; const float* bq = w_pd + (size_t)(hd * 64) * D + n;
            float s = 0.f;
            for (int d = 0; d < 64; ++d) s += a[d] * bq[(size_t)d * D];
            WC[(size_t)n * 1024 + k] = (bf16)f2bf(s);
        }
        __syncthreads();
        {
            LAS float* CA = (LAS float*)lds;
            for (int e = tid; e < BATCH * D; e += 512) { const int bb = e >> 10, k = e & 1023; const float v = cc[e]; CA[k * 32 + bb] = v / (1.0f + __expf(-v)); }
            __syncthreads();
            for (int item = wave * G + bx; item < MODW / 32; item += NGW) {
                const int col = 32 * item + (lane & 31), kh = lane >> 5;
                float acc[32];
#pragma unroll
                for (int bb = 0; bb < 32; ++bb) acc[bb] = 0.f;
                for (int k = kh * 512; k < kh * 512 + 512; ++k) {
                    const float wv = w_ada[(size_t)k * MODW + col];
#pragma unroll
                    for (int b4 = 0; b4 < 8; ++b4) { const f32x4 cv = *(const LAS f32x4*)(CA + k * 32 + 4 * b4); acc[4 * b4] += cv.x * wv; acc[4 * b4 + 1] += cv.y * wv; acc[4 * b4 + 2] += cv.z * wv; acc[4 * b4 + 3] += cv.w * wv; }
                }
                const float bv = b_ada[col];
#pragma unroll
                for (int bb = 0; bb < 32; ++bb) { const float t = acc[bb] + __shfl_xor(acc[bb], 32); if (lane < 32) MODS[(size_t)bb * MODW + col] = t + bv; }
            }
            __syncthreads();
        }
    }
    SEAM(0);
    if (IN(1)) normmod_phase(x, g_ffn1, MODS + 0 * D, MODS + 1 * D, XN, gw, NGW, lane);
    SEAM(1);
    if (IN(2)) { pg8::Gemm g{XN, WT1A, M, 2 * FF, D}; pg8::StaticOrder S; S.init(M, 2 * FF, G, bx); pg8::EpiSwiglu E{U, FF};
        pg8::gemm_phase<pg8::EpiSwiglu, pg8::StaticOrder, true, true>(lds, g, S, E); }
    SEAM(2);
    if (IN(3)) { pg8::Gemm g{U, W2TA, M, D, FF}; pg8::StaticOrder S; S.init(M, D, G, bx); pg8::EpiResid E{x, out, D, MODS + 2 * D, MODW, 0.5f};
        pg8::gemm_phase<pg8::EpiResid, pg8::StaticOrder, true, true>(lds, g, S, E); }
    SEAM(3);
    if (IN(4)) normmod_phase(out, g_mix, MODS + 3 * D, MODS + 4 * D, XN, gw, NGW, lane);
    SEAM(4);
    if (IN(5)) { pg8::Gemm g{XN, WIN, M, PW, D}; pg8::StaticOrder S; S.init(M, PW, G, bx); pg8::EpiStore2 E{PB, PW, 1 << 30, PB, PW};
        pg8::gemm_phase<pg8::EpiStore2, pg8::StaticOrder, true, true>(lds, g, S, E); }
    SEAM(5);
    if (IN(6)) smallnorm_phase(PB, g_cq, g_ckv, g_kidx, b_kidx, CQN, CKVN, KIDXN, WIDX, gw, NGW, lane);
    SEAM(6);
    if (IN(7)) { pg8::Gemm g{CQN, WQ, M, 1280, 256}; pg8::StaticOrder S; S.init(M, 1280, G, bx); pg8::EpiStore2 E{QLAT, 1024, 4, QIDX, 256};
        pg8::gemm_phase<pg8::EpiStore2, pg8::StaticOrder, true, true>(lds, g, S, E); }
    SEAM(7);
    if (IN(8)) {
        for (int idx = bx; idx < BATCH * 64; idx += G) {
            const int i = idx / G, c = idx % G;
            int b, qt;
            if (G == 256) { b = c & 31; const int hi3 = c >> 5; qt = (i & 1) ? (8 * i + 7 - hi3) : (8 * i + hi3); }
            else { b = idx & 31; qt = idx >> 5; }
            dsa_unit(lds, b, qt, QIDX, KIDXN, WIDX, QLAT, CKVN, OLAT, tid, lane, wave);
        }
        for (int bh = bx; bh < BATCH * 8; bh += G) moba_bh(lds, bh >> 3, bh & 7, PB, OMOBA, tid, lane, wave);
    }
    SEAM(8);
    if (IN(9)) { pg8::Gemm g{OLAT, WC, M, D, 1024}; pg8::StaticOrder S; S.init(M, D, G, bx); pg8::EpiGate<false> E{T1, nullptr, D, PB + PC_GA, PW};
        pg8::gemm_phase<pg8::EpiGate<false>, pg8::StaticOrder, true, true>(lds, g, S, E); }
    SEAM(9);
    if (IN(10)) { pg8::Gemm g{OMOBA, WPM, M, D, 512}; pg8::StaticOrder S; S.init(M, D, G, bx); pg8::EpiGate<true> E{Y, T1, D, PB + PC_GB, PW};
        pg8::gemm_phase<pg8::EpiGate<true>, pg8::StaticOrder, true, true>(lds, g, S, E); }
    SEAM(10);
    if (IN(11)) { pg8::Gemm g{Y, WOUT, M, D, D}; pg8::StaticOrder S; S.init(M, D, G, bx); pg8::EpiResid E{out, out, D, MODS + 5 * D, MODW, 1.0f};
        pg8::gemm_phase<pg8::EpiResid, pg8::StaticOrder, true, true>(lds, g, S, E); }
    SEAM(11);
    if (IN(12)) normmod_phase(out, g_ffn2, MODS + 6 * D, MODS + 7 * D, XN, gw, NGW, lane);
    SEAM(12);
    if (IN(13)) { pg8::Gemm g{XN, WT1B, M, 2 * FF, D}; pg8::StaticOrder S; S.init(M, 2 * FF, G, bx); pg8::EpiSwiglu E{U, FF};
        pg8::gemm_phase<pg8::EpiSwiglu, pg8::StaticOrder, true, true>(lds, g, S, E); }
    SEAM(13);
    if (IN(14)) { pg8::Gemm g{U, W2TB, M, D, FF}; pg8::StaticOrder S; S.init(M, D, G, bx); pg8::EpiResid E{out, out, D, MODS + 8 * D, MODW, 0.5f};
        pg8::gemm_phase<pg8::EpiResid, pg8::StaticOrder, true, true>(lds, g, S, E); }
    SEAM(14);
    if (IN(15)) finalnorm_phase(out, g_final, out, gw, NGW, lane);
#undef IN
#undef SEAM
}

extern "C" void kernel_launch(void* const* d_in, const int* in_sizes, int n_in, void* d_out, int out_size, void* d_ws, size_t ws_size, hipStream_t stream) {
    static int grid = 0;
    if (grid == 0) {
        if (n_in != 26 || in_sizes[0] != M * D || out_size != M * D || ws_size < WS_END) { fprintf(stderr, "kernel_launch: unexpected shapes (n_in %d, in0 %d, out %d, ws %zu)\n", n_in, n_in > 0 ? in_sizes[0] : -1, out_size, ws_size); grid = -1; return; }
        int dev = 0, cus = 0, per_cu = 0;
        if (hipGetDevice(&dev) != hipSuccess || hipDeviceGetAttribute(&cus, hipDeviceAttributeMultiprocessorCount, dev) != hipSuccess) { grid = -1; return; }
        if (hipFuncSetAttribute((const void*)mk_fwd, hipFuncAttributeMaxDynamicSharedMemorySize, LDS_BYTES) != hipSuccess) { fprintf(stderr, "kernel_launch: hipFuncSetAttribute failed\n"); grid = -1; return; }
        if (hipOccupancyMaxActiveBlocksPerMultiprocessor(&per_cu, (const void*)mk_fwd, NWAVES * 64, LDS_BYTES) != hipSuccess || per_cu < 1) fprintf(stderr, "kernel_launch: occupancy query reports %d\n", per_cu);
        (void)hipGetLastError();
        grid = cus;
    }
    if (grid < 0) return;
    if (hipMemsetAsync((char*)d_ws + WS_CTL, 0, CTL_ZERO_BYTES, stream) != hipSuccess) return;
    Args a{};
    for (int i = 0; i < 26; ++i) a.in[i] = (const float*)d_in[i];
    a.out = (float*)d_out; a.ws = (unsigned char*)d_ws;
    if (MK_ONE_LAUNCH) { a.ph_lo = 0; a.ph_hi = NPHASE; hipLaunchKernelGGL(mk_fwd, dim3(grid), dim3(NWAVES * 64), LDS_BYTES, stream, a); }
    else for (int p = 0; p < NPHASE; ++p) { a.ph_lo = p; a.ph_hi = p + 1; hipLaunchKernelGGL(mk_fwd, dim3(grid), dim3(NWAVES * 64), LDS_BYTES, stream, a); }
}
```

```cpp
#include <hip/hip_runtime.h>
#include <cstdio>
#include <cstdint>
__device__ __forceinline__ int lane_id() { return (int)__builtin_amdgcn_mbcnt_hi(~0u, __builtin_amdgcn_mbcnt_lo(~0u, 0u)); }
namespace pg8 {
#define PG8_LAS __attribute__((address_space(3)))
typedef unsigned short bf16_t;
typedef short bf16x8 __attribute__((ext_vector_type(8)));
typedef float f32x4 __attribute__((ext_vector_type(4)));
typedef unsigned u32x4 __attribute__((ext_vector_type(4)));
constexpr int BM = 256, BK = 64, HALF = 128, HTB = HALF * BK * 2  , STAGE_BYTES = 8 * HTB, NXCD = 8, WGM = 8;

__host__ __device__ __forceinline__ int lds_byte(int r, int c) { const int st = (r >> 4) * 2 + (c >> 5), rr = r & 15, cc = c & 31, ob = rr * 64 + cc * 2; return st * 1024 + (ob ^ (((ob >> 9) & 1) << 5)); }
__host__ __device__ __forceinline__ void stage_rc(int b, int& R, int& C) { const int st = b / 1024, sb = b % 1024, swz = sb ^ (((sb >> 9) & 1) << 5); R = (st >> 1) * 16 + swz / 64; C = (st & 1) * 32 + (swz % 64) / 2; }
__host__ __device__ __forceinline__ int perm32(int rho) { const int n = rho >> 4, i = rho & 15; return 8 * (i >> 2) + 4 * n + (i & 3); }

struct Unit { int pm, pn; };
struct Gemm { const bf16_t* A; const bf16_t* Bt; int M, N, K; };

struct StaticOrder {
    int nM, nN, nwg, G, c;
    __host__ __device__ void init(int M, int N, int G_, int c_) { nM = M / BM; nN = N / BM; nwg = nM * nN; G = G_; c = c_; }
    __host__ __device__ bool next(int i, Unit& u) const {
        const long L = (long)i * G + c; if (L >= nwg) return false;
        int wgid = (int)L; { const int q = nwg / NXCD, r = nwg % NXCD, xcd = wgid % NXCD, off = wgid / NXCD; wgid = (xcd < r ? xcd * (q + 1) : r * (q + 1) + (xcd - r) * q) + off; }
        const int nig = WGM * nN, gid = wgid / nig, fm = gid * WGM, gsz = (nM - fm) < WGM ? (nM - fm) : WGM;
        u.pm = fm + ((wgid % nig) % gsz); u.pn = (wgid % nig) / gsz; return true;
    }
    __device__ __forceinline__ void a_ready(const Unit&) const {}
    __device__ __forceinline__ void done(const Unit&) const {}
};

__device__ __forceinline__ unsigned cvt_pk_bf16(float lo, float hi) { unsigned r; asm volatile("v_cvt_pk_bf16_f32 %0, %1, %2" : "=v"(r) : "v"(lo), "v"(hi)); return r; }
typedef unsigned u32x2 __attribute__((ext_vector_type(2)));
typedef float f32x2 __attribute__((ext_vector_type(2)));
__device__ __forceinline__ float bflo(unsigned w) { return __uint_as_float(w << 16); }
__device__ __forceinline__ float bfhi(unsigned w) { return __uint_as_float(w & 0xffff0000u); }
__device__ __forceinline__ float fast_sigmoid(float x) { return __builtin_amdgcn_rcpf(1.0f + __builtin_amdgcn_exp2f(-1.4426950408889634f * x)); }

struct EpiSwiglu {
    static constexpr bool PERM = true, AFTER_DRAIN = false;
    bf16_t* O; int ldc;
    __device__ __forceinline__ void operator()(const f32x4 (&acc)[2][2][4][2], const Unit& u, int wr, int wc, int fr_, int fq_) const {
        int fr = fr_, fq = fq_; asm volatile("" : "+v"(fr), "+v"(fq));
        const int row0 = u.pm * BM + wr * 64 + fr, col0 = u.pn * HALF + wc * 32 + 8 * fq;
#pragma unroll
        for (int ai = 0; ai < 2; ++ai)
#pragma unroll
            for (int m = 0; m < 4; ++m) {
                bf16_t* rowp = O + (size_t)(row0 + ai * HALF + m * 16) * ldc + col0;
                float o[8];
#pragma unroll
                for (int n = 0; n < 2; ++n)
#pragma unroll
                    for (int j = 0; j < 4; j += 2) { const f32x2 a = (f32x2){acc[ai][0][m][n][j], acc[ai][0][m][n][j + 1]}, g = (f32x2){acc[ai][1][m][n][j], acc[ai][1][m][n][j + 1]};
                        const f32x2 t = a * (-1.4426950408889634f); f32x2 e; e.x = __builtin_amdgcn_exp2f(t.x); e.y = __builtin_amdgcn_exp2f(t.y);
                        const f32x2 d = e + 1.0f; f32x2 rc; rc.x = __builtin_amdgcn_rcpf(d.x); rc.y = __builtin_amdgcn_rcpf(d.y);
                        const f32x2 r2 = (a * g) * rc; o[4 * n + j] = r2.x; o[4 * n + j + 1] = r2.y; }
                u32x4 w; w.x = cvt_pk_bf16(o[0], o[1]); w.y = cvt_pk_bf16(o[2], o[3]); w.z = cvt_pk_bf16(o[4], o[5]); w.w = cvt_pk_bf16(o[6], o[7]);
                *(u32x4*)rowp = w;
            }
    }
};
struct EpiSwigluI8 {
    static constexpr bool PERM = true, AFTER_DRAIN = false;
    bf16_t* O; int ldc; const float* sa; const float* sb;
    __device__ __forceinline__ void operator()(const f32x4 (&acc)[2][2][4][2], const Unit& u, int wr, int wc, int fr_, int fq_) const {
        int fr = fr_, fq = fq_; asm volatile("" : "+v"(fr), "+v"(fq));
        typedef int v4i_ __attribute__((ext_vector_type(4)));
        const int row0 = u.pm * BM + wr * 64 + fr, col0 = u.pn * HALF + wc * 32 + 8 * fq;
        const float* bp = sb + u.pn * BM + wc * 32 + 8 * fq;
        f32x4 s1[2], s3[2];
#pragma unroll
        for (int n = 0; n < 2; ++n) { s1[n] = *(const f32x4*)(bp + 4 * n); s3[n] = *(const f32x4*)(bp + HALF + 4 * n); }
#pragma unroll
        for (int ai = 0; ai < 2; ++ai)
#pragma unroll
            for (int m = 0; m < 4; ++m) {
                const int row = row0 + ai * HALF + m * 16; const float ra = sa[row] * (1.0f / 127.0f);
                bf16_t* rowp = O + (size_t)row * ldc + col0;
                float o[8];
#pragma unroll
                for (int n = 0; n < 2; ++n) { const v4i_ ia = __builtin_bit_cast(v4i_, acc[ai][0][m][n]), ig = __builtin_bit_cast(v4i_, acc[ai][1][m][n]);
#pragma unroll
                    for (int j = 0; j < 4; j += 2) { const f32x2 a = (f32x2){(float)ia[j], (float)ia[j + 1]} * ((f32x2){s1[n][j], s1[n][j + 1]} * ra), g = (f32x2){(float)ig[j], (float)ig[j + 1]} * ((f32x2){s3[n][j], s3[n][j + 1]} * ra);
                        const f32x2 t = a * (-1.4426950408889634f); f32x2 e; e.x = __builtin_amdgcn_exp2f(t.x); e.y = __builtin_amdgcn_exp2f(t.y);
                        const f32x2 d = e + 1.0f; f32x2 rc; rc.x = __builtin_amdgcn_rcpf(d.x); rc.y = __builtin_amdgcn_rcpf(d.y);
                        const f32x2 r2 = (a * g) * rc; o[4 * n + j] = r2.x; o[4 * n + j + 1] = r2.y; } }
                u32x4 w; w.x = cvt_pk_bf16(o[0], o[1]); w.y = cvt_pk_bf16(o[2], o[3]); w.z = cvt_pk_bf16(o[4], o[5]); w.w = cvt_pk_bf16(o[6], o[7]);
                *(u32x4*)rowp = w;
            }
    }
};
struct EpiStoreI8 {
    static constexpr bool PERM = true, AFTER_DRAIN = false;
    bf16_t* O; int ldc; const float* sa; const float* sb; int pn_lo, pn_hi; float qscale;
    __device__ __forceinline__ void operator()(const f32x4 (&acc)[2][2][4][2], const Unit& u, int wr, int wc, int fr_, int fq_) const {
        int fr = fr_, fq = fq_; asm volatile("" : "+v"(fr), "+v"(fq));
        typedef int v4i_ __attribute__((ext_vector_type(4)));
        const int row0 = u.pm * BM + wr * 64 + fr, col0 = u.pn * BM + wc * 32 + 8 * fq;
        const float cs = (u.pn >= pn_lo && u.pn < pn_hi) ? qscale * (1.0f / 127.0f) : (1.0f / 127.0f);
        f32x4 bb[2][2];
#pragma unroll
        for (int bj = 0; bj < 2; ++bj)
#pragma unroll
            for (int n = 0; n < 2; ++n) bb[bj][n] = *(const f32x4*)(sb + col0 + bj * HALF + 4 * n) * cs;
#pragma unroll
        for (int ai = 0; ai < 2; ++ai)
#pragma unroll
            for (int m = 0; m < 4; ++m) {
                const int row = row0 + ai * HALF + m * 16; const float ra = sa[row];
                bf16_t* rowp = O + (size_t)row * ldc + col0;
#pragma unroll
                for (int bj = 0; bj < 2; ++bj) {
                    const v4i_ i0 = __builtin_bit_cast(v4i_, acc[ai][bj][m][0]), i1 = __builtin_bit_cast(v4i_, acc[ai][bj][m][1]);
                    const f32x4 v0 = (f32x4){(float)i0[0], (float)i0[1], (float)i0[2], (float)i0[3]} * (bb[bj][0] * ra), v1 = (f32x4){(float)i1[0], (float)i1[1], (float)i1[2], (float)i1[3]} * (bb[bj][1] * ra);
                    u32x4 w; w.x = cvt_pk_bf16(v0[0], v0[1]); w.y = cvt_pk_bf16(v0[2], v0[3]); w.z = cvt_pk_bf16(v1[0], v1[1]); w.w = cvt_pk_bf16(v1[2], v1[3]);
                    *(u32x4*)(rowp + bj * HALF) = w;
                }
            }
    }
};
struct EpiResid {
    static constexpr bool PERM = false, AFTER_DRAIN = false;
    const float* base; float* out; int ldc; const float* gate; int gstride; float coef;
    __device__ __forceinline__ void operator()(const f32x4 (&acc)[2][2][4][2], const Unit& u, int wr, int wc, int fr_, int fq_) const {
        int fr = fr_, fq = fq_; asm volatile("" : "+v"(fr), "+v"(fq));
        const float* gp = gate + (size_t)(u.pm >> 3) * gstride;
        const int col0 = u.pn * BM + wc * 32 + 4 * fq;
#pragma unroll
        for (int bj = 0; bj < 2; ++bj)
#pragma unroll
            for (int n = 0; n < 2; ++n) {
                const f32x4 gv = *(const f32x4*)(gp + col0 + bj * HALF + n * 16);
                const f32x4 s = (gv + 1.0f) * coef;
#pragma unroll
                for (int ai = 0; ai < 2; ++ai)
#pragma unroll
                    for (int m = 0; m < 4; ++m) {
                        const size_t off = (size_t)(u.pm * BM + ai * HALF + wr * 64 + m * 16 + fr) * ldc + col0 + bj * HALF + n * 16;
                        const f32x4 bs = *(const f32x4*)(base + off);
                        *(f32x4*)(out + off) = bs + s * acc[ai][bj][m][n];
                    }
            }
    }
};
template <bool BASE_BF16, bool I8, bool HALF_COEF> struct EpiResidB {
    static constexpr bool PERM = true, AFTER_DRAIN = false;
    const void* base; bf16_t* out; int ldc; const float* gate; int gstride; const float* sa; const float* sb;
    __device__ __forceinline__ void operator()(const f32x4 (&acc)[2][2][4][2], const Unit& u, int wr, int wc, int fr_, int fq_) const {
        int fr = fr_, fq = fq_; asm volatile("" : "+v"(fr), "+v"(fq));
        const float* gp = gate + (size_t)(u.pm >> 3) * gstride;
        const int row0 = u.pm * BM + wr * 64 + fr, col0 = u.pn * BM + wc * 32 + 8 * fq;
        f32x4 sv[2][2];
#pragma unroll
        for (int bj = 0; bj < 2; ++bj)
#pragma unroll
            for (int n = 0; n < 2; ++n) { sv[bj][n] = (*(const f32x4*)(gp + col0 + bj * HALF + 4 * n) + 1.0f) * (HALF_COEF ? 0.5f : 1.0f); if (I8) sv[bj][n] = sv[bj][n] * (*(const f32x4*)(sb + col0 + bj * HALF + 4 * n) * (1.0f / 127.0f)); }
#pragma unroll
        for (int ai = 0; ai < 2; ++ai)
#pragma unroll
            for (int m = 0; m < 4; ++m) {
                const size_t roff = (size_t)(row0 + ai * HALF + m * 16) * ldc + col0; float ra = 1.0f; if (I8) ra = sa[row0 + ai * HALF + m * 16];
#pragma unroll
                for (int bj = 0; bj < 2; ++bj) {
                    f32x4 b0, b1;
                    if (BASE_BF16) { const u32x4 bw = *(const u32x4*)((const bf16_t*)base + roff + bj * HALF); b0 = (f32x4){bflo(bw.x), bfhi(bw.x), bflo(bw.y), bfhi(bw.y)}; b1 = (f32x4){bflo(bw.z), bfhi(bw.z), bflo(bw.w), bfhi(bw.w)}; }
                    else { b0 = *(const f32x4*)((const float*)base + roff + bj * HALF); b1 = *(const f32x4*)((const float*)base + roff + bj * HALF + 4); }
                    f32x4 a0 = acc[ai][bj][m][0], a1 = acc[ai][bj][m][1];
                    if (I8) { typedef int v4i_ __attribute__((ext_vector_type(4))); const v4i_ i0 = __builtin_bit_cast(v4i_, a0), i1 = __builtin_bit_cast(v4i_, a1);
                        a0 = (f32x4){(float)i0[0], (float)i0[1], (float)i0[2], (float)i0[3]} * ra; a1 = (f32x4){(float)i1[0], (float)i1[1], (float)i1[2], (float)i1[3]} * ra; }
                    const f32x4 o0 = b0 + sv[bj][0] * a0, o1 = b1 + sv[bj][1] * a1;
                    u32x4 w; w.x = cvt_pk_bf16(o0[0], o0[1]); w.y = cvt_pk_bf16(o0[2], o0[3]); w.z = cvt_pk_bf16(o1[0], o1[1]); w.w = cvt_pk_bf16(o1[2], o1[3]);
                    *(u32x4*)(out + roff + bj * HALF) = w;
                }
            }
    }
};
struct EpiStore2 {
    static constexpr bool PERM = true, AFTER_DRAIN = false;
    bf16_t* O0; int ld0; int split_pn; bf16_t* O1; int ld1;
    __device__ __forceinline__ void operator()(const f32x4 (&acc)[2][2][4][2], const Unit& u, int wr, int wc, int fr_, int fq_) const {
        int fr = fr_, fq = fq_; asm volatile("" : "+v"(fr), "+v"(fq));
        const bool first = u.pn < split_pn;
        bf16_t* base = first ? O0 : O1; const int ld = first ? ld0 : ld1; const int colt = (first ? u.pn : u.pn - split_pn) * BM;
        const int row0 = u.pm * BM + wr * 64 + fr, col0 = colt + wc * 32 + 8 * fq;
#pragma unroll
        for (int ai = 0; ai < 2; ++ai)
#pragma unroll
            for (int m = 0; m < 4; ++m) {
                bf16_t* rowp = base + (size_t)(row0 + ai * HALF + m * 16) * ld + col0;
#pragma unroll
                for (int bj = 0; bj < 2; ++bj) {
                    const f32x4 v0 = acc[ai][bj][m][0], v1 = acc[ai][bj][m][1];
                    u32x4 w; w.x = cvt_pk_bf16(v0[0], v0[1]); w.y = cvt_pk_bf16(v0[2], v0[3]); w.z = cvt_pk_bf16(v1[0], v1[1]); w.w = cvt_pk_bf16(v1[2], v1[3]);
                    *(u32x4*)(rowp + bj * HALF) = w;
                }
            }
    }
};
template <bool HAS_ADD> struct EpiGate {
    static constexpr bool PERM = true, AFTER_DRAIN = false;
    bf16_t* O; const bf16_t* add; int ldc; const bf16_t* G; int ldg;
    __device__ __forceinline__ void operator()(const f32x4 (&acc)[2][2][4][2], const Unit& u, int wr, int wc, int fr_, int fq_) const {
        int fr = fr_, fq = fq_; asm volatile("" : "+v"(fr), "+v"(fq));
        const int row0 = u.pm * BM + wr * 64 + fr, col0 = u.pn * BM + wc * 32 + 8 * fq;
#pragma unroll
        for (int ai = 0; ai < 2; ++ai)
#pragma unroll
            for (int m = 0; m < 4; ++m) {
                const size_t row = (size_t)(row0 + ai * HALF + m * 16);
#pragma unroll
                for (int bj = 0; bj < 2; ++bj) {
                    const u32x4 gw = *(const u32x4*)(G + row * ldg + col0 + bj * HALF);
                    u32x4 aw = (u32x4){0u, 0u, 0u, 0u};
                    if (HAS_ADD) aw = *(const u32x4*)(add + row * ldc + col0 + bj * HALF);
                    const f32x4 v0 = acc[ai][bj][m][0], v1 = acc[ai][bj][m][1];
                    float o[8];
                    o[0] = bflo(aw.x) + fast_sigmoid(bflo(gw.x)) * v0[0]; o[1] = bfhi(aw.x) + fast_sigmoid(bfhi(gw.x)) * v0[1];
                    o[2] = bflo(aw.y) + fast_sigmoid(bflo(gw.y)) * v0[2]; o[3] = bfhi(aw.y) + fast_sigmoid(bfhi(gw.y)) * v0[3];
                    o[4] = bflo(aw.z) + fast_sigmoid(bflo(gw.z)) * v1[0]; o[5] = bfhi(aw.z) + fast_sigmoid(bfhi(gw.z)) * v1[1];
                    o[6] = bflo(aw.w) + fast_sigmoid(bflo(gw.w)) * v1[2]; o[7] = bfhi(aw.w) + fast_sigmoid(bfhi(gw.w)) * v1[3];
                    u32x4 w; w.x = cvt_pk_bf16(o[0], o[1]); w.y = cvt_pk_bf16(o[2], o[3]); w.z = cvt_pk_bf16(o[4], o[5]); w.w = cvt_pk_bf16(o[6], o[7]);
                    *(u32x4*)(O + row * ldc + col0 + bj * HALF) = w;
                }
            }
    }
};

template <class Epi, class Sched, bool ALIGN_EPI = false, bool SP2 = false, bool I8 = false>
__device__ __forceinline__ void gemm_phase(PG8_LAS unsigned char* lds, const Gemm g, const Sched& S, const Epi& E, const int wave_) {
    int lane_o_ = lane_id(); asm volatile("" : "+v"(lane_o_));
    const int lane = lane_o_, wid = wave_, tid = wid * 64 + lane, wr = wid >> 2, wc = wid & 3, fr = lane & 15, fq = lane >> 4;
    const int K = g.K, nt = K / BK;
    unsigned voffA[2], voffB[2];
#pragma unroll
    for (int i = 0; i < 2; ++i) { int R, C; stage_rc(tid * 16 + i * 8192, R, C); const int Rb = Epi::PERM ? ((R & ~31) + perm32(R & 31)) : R;
        voffA[i] = (unsigned)(R * K + C) * 2u; voffB[i] = (unsigned)(Rb * K + C) * 2u; }
    const size_t kstep = (size_t)(BK * 2);
    const size_t hstep = (size_t)HALF * K * 2;
    const size_t tstep = 2 * hstep;
    const unsigned ldsw = (unsigned)wid * 1024u;
    const int aoff = lds_byte(wr * 64 + fr, fq * 8), boff = lds_byte(wc * 32 + fr, fq * 8);
#define PG8_SA(b, h) (((b) * 2 + (h)) * HTB)
#define PG8_SB(b, h) ((4 + (b) * 2 + (h)) * HTB)
#define PG8_STAGE(bufoff, gbase, voff) do { _Pragma("unroll") for (int _i = 0; _i < 2; ++_i) \
        __builtin_amdgcn_global_load_lds((const unsigned*)((const char*)(gbase) + (voff)[_i]), (PG8_LAS unsigned*)(lds + (bufoff) + ldsw + _i * 8192), 16, 0, 0); } while (0)
#define PG8_LDA(dst, b, h) do { _Pragma("unroll") for (int m = 0; m < 4; ++m) _Pragma("unroll") for (int k = 0; k < 2; ++k) dst[m][k] = *(const PG8_LAS bf16x8*)(lds + PG8_SA(b, h) + aoff + m * 2048 + k * 1024); } while (0)
#define PG8_LDB(dst, b, h) do { _Pragma("unroll") for (int n = 0; n < 2; ++n) _Pragma("unroll") for (int k = 0; k < 2; ++k) dst[n][k] = *(const PG8_LAS bf16x8*)(lds + PG8_SB(b, h) + boff + n * 2048 + k * 1024); } while (0)
#define PG8_MMA(ai, bj, At, Bt) do { __builtin_amdgcn_s_setprio(1); _Pragma("unroll") for (int m = 0; m < 4; ++m) _Pragma("unroll") for (int n = 0; n < 2; ++n) _Pragma("unroll") for (int k = 0; k < 2; ++k) { \
        if constexpr (I8) { typedef int v4i_ __attribute__((ext_vector_type(4))); \
            acc[ai][bj][m][n] = __builtin_bit_cast(f32x4, __builtin_amdgcn_mfma_i32_16x16x64_i8(__builtin_bit_cast(v4i_, Bt[n][k]), __builtin_bit_cast(v4i_, At[m][k]), __builtin_bit_cast(v4i_, acc[ai][bj][m][n]), 0, 0, 0)); } \
        else acc[ai][bj][m][n] = __builtin_amdgcn_mfma_f32_16x16x32_bf16(Bt[n][k], At[m][k], acc[ai][bj][m][n], 0, 0, 0); } \
        __builtin_amdgcn_s_setprio(0); } while (0)
#define PG8_WAIT_V(n) asm volatile("s_waitcnt vmcnt(" #n ")" ::: "memory")
#define PG8_WAIT_L(n) asm volatile("s_waitcnt lgkmcnt(" #n ")" ::: "memory")
#define PG8_BAR __builtin_amdgcn_s_barrier()
#define PG8_SCHED __builtin_amdgcn_sched_barrier(0)
    Unit cur, nxt; int ui = 0;
    if (!S.next(0, cur)) return;
    f32x4 acc[2][2][4][2];
#pragma unroll
    for (int a = 0; a < 2; ++a)
#pragma unroll
        for (int b = 0; b < 2; ++b)
#pragma unroll
            for (int m = 0; m < 4; ++m)
#pragma unroll
                for (int n = 0; n < 2; ++n) acc[a][b][m][n] = (f32x4){0.f, 0.f, 0.f, 0.f};
    bf16x8 At[4][2], B0[2][2], B1[2][2];
    const char* cA = (const char*)g.A + (size_t)cur.pm * tstep; const char* cB = (const char*)g.Bt + (size_t)cur.pn * tstep;
    S.a_ready(cur);
    if constexpr (SP2) {
        PG8_STAGE(PG8_SB(0, 0), cB, voffB); PG8_STAGE(PG8_SB(0, 1), cB + hstep, voffB); PG8_STAGE(PG8_SA(0, 0), cA, voffA); PG8_STAGE(PG8_SA(0, 1), cA + hstep, voffA);
        if (wr == 1) PG8_BAR;
        PG8_WAIT_V(2); PG8_BAR;
        PG8_STAGE(PG8_SB(1, 0), cB + kstep, voffB); PG8_STAGE(PG8_SA(1, 0), cA + kstep, voffA); PG8_STAGE(PG8_SB(1, 1), cB + hstep + kstep, voffB);
        PG8_WAIT_V(6); PG8_BAR;
    } else {
        PG8_STAGE(PG8_SB(0, 0), cB, voffB); PG8_STAGE(PG8_SA(0, 0), cA, voffA); PG8_STAGE(PG8_SB(0, 1), cB + hstep, voffB); PG8_STAGE(PG8_SA(0, 1), cA + hstep, voffA);
        if (wr == 1) PG8_BAR;
        PG8_WAIT_V(4); PG8_BAR;
        PG8_STAGE(PG8_SB(1, 0), cB + kstep, voffB); PG8_STAGE(PG8_SA(1, 0), cA + kstep, voffA); PG8_STAGE(PG8_SB(1, 1), cB + hstep + kstep, voffB);
        PG8_WAIT_V(6); PG8_BAR;
    }
    for (;;) {
        const bool has_next = S.next(ui + 1, nxt);
        const char* nA = has_next ? (const char*)g.A + (size_t)nxt.pm * tstep : cA; const char* nB = has_next ? (const char*)g.Bt + (size_t)nxt.pn * tstep : cB;
        for (int t = 0; t < nt; t += 2) {
            const bool last = (t == nt - 2);
            const char* a1 = cA + (size_t)(t + 1) * kstep;
            const char* a2 = last ? nA : cA + (size_t)(t + 2) * kstep; const char* b2 = last ? nB : cB + (size_t)(t + 2) * kstep;
            const char* a3 = a2 + kstep; const char* b3 = b2 + kstep;
            if (last && has_next) S.a_ready(nxt);
            if constexpr (SP2) {
            PG8_LDB(B0, 0, 0); PG8_LDB(B1, 0, 1); PG8_SCHED; PG8_LDA(At, 0, 0); PG8_STAGE(PG8_SA(1, 1), a1 + hstep, voffA);
            PG8_WAIT_V(8); PG8_WAIT_L(0); PG8_BAR; PG8_MMA(0, 0, At, B0); PG8_MMA(0, 1, At, B1); PG8_BAR; PG8_SCHED;
            PG8_LDA(At, 0, 1); PG8_STAGE(PG8_SB(0, 0), b2, voffB); PG8_STAGE(PG8_SB(0, 1), b2 + hstep, voffB); PG8_STAGE(PG8_SA(0, 0), a2, voffA);
            PG8_WAIT_V(8); PG8_WAIT_L(0); PG8_BAR; PG8_MMA(1, 0, At, B0); PG8_MMA(1, 1, At, B1); PG8_BAR; PG8_SCHED;
            PG8_LDB(B0, 1, 0); PG8_LDB(B1, 1, 1); PG8_SCHED; PG8_LDA(At, 1, 0); PG8_STAGE(PG8_SA(0, 1), a2 + hstep, voffA);
            PG8_WAIT_V(8); PG8_WAIT_L(0); PG8_BAR; PG8_MMA(0, 0, At, B0); PG8_MMA(0, 1, At, B1); PG8_BAR; PG8_SCHED;
            PG8_LDA(At, 1, 1); PG8_STAGE(PG8_SB(1, 0), b3, voffB); PG8_STAGE(PG8_SB(1, 1), b3 + hstep, voffB); PG8_STAGE(PG8_SA(1, 0), a3, voffA);
            PG8_WAIT_V(8); PG8_WAIT_L(0); PG8_BAR; PG8_MMA(1, 0, At, B0); PG8_MMA(1, 1, At, B1); PG8_BAR; PG8_SCHED;
            } else {
            PG8_LDB(B0, 0, 0); PG8_SCHED; PG8_LDA(At, 0, 0); PG8_STAGE(PG8_SA(1, 1), a1 + hstep, voffA);
            PG8_WAIT_L(8); PG8_BAR; PG8_WAIT_L(0); PG8_MMA(0, 0, At, B0); PG8_BAR; PG8_SCHED;
            PG8_LDB(B1, 0, 1); PG8_STAGE(PG8_SB(0, 0), b2, voffB);
            PG8_BAR; PG8_WAIT_L(0); PG8_MMA(0, 1, At, B1); PG8_BAR;
            PG8_LDA(At, 0, 1); PG8_STAGE(PG8_SA(0, 0), a2, voffA);
            PG8_BAR; PG8_WAIT_L(0); PG8_MMA(1, 0, At, B0); PG8_BAR; PG8_SCHED;
            PG8_STAGE(PG8_SB(0, 1), b2 + hstep, voffB);
            PG8_WAIT_V(6); PG8_BAR; PG8_MMA(1, 1, At, B1); PG8_BAR;
            PG8_LDB(B0, 1, 0); PG8_SCHED; PG8_LDA(At, 1, 0); PG8_STAGE(PG8_SA(0, 1), a2 + hstep, voffA);
            PG8_WAIT_L(8); PG8_BAR; PG8_WAIT_L(0); PG8_MMA(0, 0, At, B0); PG8_BAR; PG8_SCHED;
            PG8_LDB(B1, 1, 1); PG8_STAGE(PG8_SB(1, 0), b3, voffB);
            PG8_BAR; PG8_WAIT_L(0); PG8_MMA(0, 1, At, B1); PG8_BAR;
            PG8_LDA(At, 1, 1); PG8_STAGE(PG8_SA(1, 0), a3, voffA);
            PG8_BAR; PG8_WAIT_L(0); PG8_MMA(1, 0, At, B0); PG8_BAR; PG8_SCHED;
            PG8_STAGE(PG8_SB(1, 1), b3 + hstep, voffB);
            PG8_WAIT_V(6); PG8_BAR; PG8_MMA(1, 1, At, B1); PG8_BAR;
            }
        }
        if constexpr (ALIGN_EPI) { if (wr == 0) PG8_BAR; }
        if constexpr (!Epi::AFTER_DRAIN) { E(acc, cur, wr, wc, fr, fq); S.done(cur); }
        if (!has_next) break;
#pragma unroll
        for (int a = 0; a < 2; ++a)
#pragma unroll
            for (int b = 0; b < 2; ++b)
#pragma unroll
                for (int m = 0; m < 4; ++m)
#pragma unroll
                    for (int n = 0; n < 2; ++n) acc[a][b][m][n] = (f32x4){0.f, 0.f, 0.f, 0.f};
        cur = nxt; cA = nA; cB = nB; ++ui;
        if constexpr (ALIGN_EPI) { if (wr == 1) PG8_BAR; }
    }
    PG8_WAIT_V(0);
    if constexpr (!ALIGN_EPI) { if (wr == 0) PG8_BAR; }
    PG8_BAR;
    if constexpr (Epi::AFTER_DRAIN) { E.fused(acc, cur, wr, wc, fr, fq, lds, wid, lane); S.done(cur); }
#undef PG8_SA
#undef PG8_SB
#undef PG8_STAGE
#undef PG8_LDA
#undef PG8_LDB
#undef PG8_MMA
#undef PG8_WAIT_V
#undef PG8_WAIT_L
#undef PG8_BAR
#undef PG8_SCHED
}
}

constexpr int NWAVES = 8;
constexpr int BATCH = 32, SEQ = 2048, D = 1024, FF = 2816, M = BATCH * SEQ;
constexpr int NMOD = 9, MODW = NMOD * D;
constexpr int INW = 4036, PW = 4096;
constexpr int PC_CQ = 0, PC_CKV = 256, PC_KIDX = 384, PC_WIDX = 448, PC_MQ = 512, PC_MK = 1024, PC_MV = 1536, PC_GA = 2048, PC_GB = 3072;
constexpr float EPS = 1e-6f, LOG2E = 1.4426950408889634f;
constexpr int NPHASE = 16;
#ifndef MK_ONE_LAUNCH
#define MK_ONE_LAUNCH 1
#endif
#ifndef PROBE_VARIANTS
#define PROBE_VARIANTS 0
#endif

constexpr size_t MiB = 1u << 20;
constexpr size_t WS_CTL = 0, CTL_ZERO_BYTES = 1 * MiB;
constexpr size_t WS_MODS = 1 * MiB;
constexpr size_t WS_WT1A = 4 * MiB, WS_W2TA = 15 * MiB, WS_WT1B = 21 * MiB, WS_W2TB = 32 * MiB, WS_WIN = 38 * MiB, WS_WQ = 46 * MiB, WS_WC = 47 * MiB, WS_WPM = 49 * MiB, WS_WOUT = 50 * MiB;
constexpr size_t WS_CQN = 52 * MiB, WS_CKVN = 84 * MiB, WS_KIDXN = 100 * MiB, WS_WIDX = 108 * MiB, WS_QIDX = 110 * MiB, WS_OMOBA = 142 * MiB;
constexpr size_t WS_XN = 206 * MiB;
constexpr size_t WS_OLAT = 334 * MiB;
constexpr size_t WS_P = 462 * MiB;
constexpr size_t WS_MASK = 974 * MiB;
constexpr size_t WS_KMG = 990 * MiB;
constexpr size_t WS_END = 991 * MiB;
constexpr int CW_BAR = 4096;

constexpr int LDSCTL_OFF = 140288, MISC_OFF = LDSCTL_OFF + 320;
constexpr int LDS_BYTES = 147456;
static_assert(MISC_OFF + 128 <= LDS_BYTES, "LDS map");

#define GAS __attribute__((address_space(1)))
#define LAS __attribute__((address_space(3)))
typedef unsigned short bf16;
typedef unsigned v4u __attribute__((ext_vector_type(4)));
typedef unsigned v2u __attribute__((ext_vector_type(2)));
typedef float f32x4 __attribute__((ext_vector_type(4)));
typedef float f32x16 __attribute__((ext_vector_type(16)));
typedef short bf16x8 __attribute__((ext_vector_type(8)));
typedef short s16x4 __attribute__((ext_vector_type(4)));
typedef short v4i16_t __attribute__((ext_vector_type(4)));
typedef GAS unsigned gu32;
#define RLX_AGENT __ATOMIC_RELAXED, __HIP_MEMORY_SCOPE_AGENT
#define LDS_WAIT() asm volatile("s_waitcnt lgkmcnt(0)" ::: "memory")
__device__ __forceinline__ unsigned f2bf(float f) { unsigned u = __builtin_bit_cast(unsigned, f); return (u + 0x7fffu + ((u >> 16) & 1u)) >> 16; }
__device__ __forceinline__ unsigned pk2(float lo, float hi) { return f2bf(lo) | (f2bf(hi) << 16); }
__device__ __forceinline__ float bf2f(bf16 v) { return __uint_as_float((unsigned)v << 16); }
__device__ __forceinline__ float wlo(unsigned w) { return __uint_as_float(w << 16); }
__device__ __forceinline__ float whi(unsigned w) { return __uint_as_float(w & 0xffff0000u); }
typedef float f32x2_t __attribute__((ext_vector_type(2))); typedef __bf16 bf16x2_t __attribute__((ext_vector_type(2)));
__device__ __forceinline__ unsigned cvtpk(float lo, float hi) { f32x2_t v = {lo, hi}; bf16x2_t b = __builtin_convertvector(v, bf16x2_t); return __builtin_bit_cast(unsigned, b); }
__device__ __forceinline__ float wave_sum(float v) {
#pragma unroll
    for (int o = 1; o < 64; o <<= 1) v += __shfl_xor(v, o);
    return v;
}

#define XB_TMO      128
#define XB_XCNT(j)  (256  + 64 * (j))
#define XB_XSUB(j)  (1280 + 64 * (j))
#define XB_XGEN(j)  (2304 + 64 * (j))
#define XB_TOP      3328
#define XB_TOPGEN   3392
#define XCD_BAR_WORDS 3456
#define XB_SPIN_CAP (1u << 18)

__device__ __forceinline__ unsigned xb_ld(unsigned* p)              { return __hip_atomic_load(p, __ATOMIC_RELAXED, __HIP_MEMORY_SCOPE_AGENT); }
__device__ __forceinline__ unsigned xb_add(unsigned* p, unsigned v) { return __hip_atomic_fetch_add(p, v, __ATOMIC_RELAXED, __HIP_MEMORY_SCOPE_AGENT); }
__device__ __forceinline__ unsigned xb_xcc_id() { return (unsigned)__builtin_amdgcn_s_getreg((3 << 11) | 20) & 0xFu; }
#define XB_SPIN(cond, bar) do { unsigned _sp = 0; while (cond) { __builtin_amdgcn_s_sleep(1); \
    if ((++_sp & 255u) == 0u) { if (xb_ld(&(bar)[XB_TMO])) break; if (_sp > XB_SPIN_CAP) { atomicAdd(&(bar)[XB_TMO], 1u); break; } } } } while (0)

struct XcdBarrier {
    unsigned* bar; unsigned x;
    volatile LAS unsigned* st;
};

__device__ __forceinline__ XcdBarrier xcd_barrier_post(unsigned* bar, volatile LAS unsigned* st) {
    XcdBarrier b; b.bar = bar; b.x = xb_xcc_id(); b.st = st;
    if (threadIdx.x == 0) (void)xb_add(&bar[XB_XCNT(b.x)], 1u);
    return b;
}
__device__ __forceinline__ void xcd_barrier_complete(unsigned* bar, unsigned x, unsigned& nloc, unsigned& nx) {
    const unsigned G = gridDim.x * gridDim.y * gridDim.z;
    unsigned sum, cnt, mine, sp = 0u;
    for (;;) {
        sum = 0u; cnt = 0u; mine = 0u;
#pragma unroll
        for (unsigned j = 0; j < 16; ++j) { const unsigned c = xb_ld(&bar[XB_XCNT(j)]); sum += c; cnt += (c > 0u) ? 1u : 0u; mine = (j == x) ? c : mine; }
        if (sum == G) break;
        __builtin_amdgcn_s_sleep(1);
        if ((++sp & 255u) == 0u) { if (xb_ld(&bar[XB_TMO])) break; if (sp > XB_SPIN_CAP) { atomicAdd(&bar[XB_TMO], 1u); break; } }
    }
    nloc = mine > 0u ? mine : 1u; nx = cnt > 0u ? cnt : 1u;
}

__device__ __forceinline__ void xcd_barrier(const XcdBarrier& b) {
    asm volatile("s_waitcnt vmcnt(0)" ::: "memory");
    __syncthreads();
    if (threadIdx.x == 0) {
        unsigned* bar = b.bar;
        __builtin_amdgcn_s_waitcnt(0);
        unsigned nloc = b.st[0], nx = b.st[1];
        if (nloc == 0u) { xcd_barrier_complete(bar, b.x, nloc, nx); b.st[0] = nloc; b.st[1] = nx; }
        const unsigned old = xb_add(&bar[XB_XSUB(b.x)], 1u);
        const unsigned gen = old / nloc;
        if (old + 1u == (gen + 1u) * nloc) {
            __builtin_amdgcn_fence(__ATOMIC_RELEASE, "agent");
            asm volatile("s_waitcnt vmcnt(0)" ::: "memory");
            const unsigned og = xb_add(&bar[XB_TOP], 1u);
            const unsigned tg = og / nx;
            if (og + 1u == (tg + 1u) * nx) xb_add(&bar[XB_TOPGEN], 1u);
            else XB_SPIN(xb_ld(&bar[XB_TOPGEN]) == tg, bar);
            __builtin_amdgcn_fence(__ATOMIC_ACQUIRE, "agent");
            xb_add(&bar[XB_XGEN(b.x)], 1u);
            asm volatile("s_waitcnt vmcnt(0)" ::: "memory");
        } else {
            XB_SPIN(xb_ld(&bar[XB_XGEN(b.x)]) == gen, bar);
            __builtin_amdgcn_fence(__ATOMIC_ACQUIRE, "agent");
            asm volatile("s_waitcnt vmcnt(0)" ::: "memory");
        }
    }
    __syncthreads();
}


__device__ __forceinline__ void tr_item(const float* W, int N, int c0, int nvalid, int k0, bf16* WT, int ldk, int drow0, LAS float* scr, int lane, float scale = 1.0f) {
#pragma unroll
    for (int i = 0; i < 32; ++i) { const int kk = 2 * i + (lane >> 5), n = lane & 31; scr[kk * 33 + n] = (n < nvalid) ? W[(size_t)(k0 + kk) * N + c0 + n] * scale : 0.f; }
    LDS_WAIT(); asm volatile("" ::: "memory");
    const int c = lane & 7;
#pragma unroll
    for (int j = 0; j < 4; ++j) { const int n = (lane >> 3) + 8 * j; const LAS float* s = scr + (8 * c) * 33 + n;
        v4u o; o.x = pk2(s[0 * 33], s[1 * 33]); o.y = pk2(s[2 * 33], s[3 * 33]); o.z = pk2(s[4 * 33], s[5 * 33]); o.w = pk2(s[6 * 33], s[7 * 33]);
        *(GAS v4u*)(WT + (size_t)(drow0 + n) * ldk + k0 + 8 * c) = o; }
    LDS_WAIT(); asm volatile("" ::: "memory");
}

__device__ __forceinline__ unsigned pk4_i8(float a, float b, float c, float d) {
    const int i0 = (int)__builtin_rintf(a), i1 = (int)__builtin_rintf(b), i2 = (int)__builtin_rintf(c), i3 = (int)__builtin_rintf(d);
    return ((unsigned)i0 & 0xffu) | (((unsigned)i1 & 0xffu) << 8) | (((unsigned)i2 & 0xffu) << 16) | ((unsigned)i3 << 24);
}
__device__ __forceinline__ void colmax_item(const float* W, int N, int c0, int k0, unsigned* CMAX, int drow0, int lane, int nvalid = 32) {
    float mx = 0.f;
#pragma unroll
    for (int i = 0; i < 32; ++i) { const int kk = 2 * i + (lane >> 5), n = lane & 31; if (n < nvalid) mx = fmaxf(mx, fabsf(W[(size_t)(k0 + kk) * N + c0 + n])); }
    mx = fmaxf(mx, __shfl_xor(mx, 32));
    if (lane < 32) atomicMax(CMAX + drow0 + lane, __float_as_uint(mx));
}
__device__ __forceinline__ void tr_item_q8(const float* W, int N, int c0, int k0, unsigned char* WT8, int ldk, int drow0, const unsigned* CMAX, LAS float* scr, int lane, int nvalid = 32) {
    const float cm = __uint_as_float(CMAX[drow0 + (lane & 31)]); const float qs = cm > 0.f ? 127.0f / cm : 0.f;
#pragma unroll
    for (int i = 0; i < 32; ++i) { const int kk = 2 * i + (lane >> 5), n = lane & 31; scr[kk * 33 + n] = (n < nvalid) ? W[(size_t)(k0 + kk) * N + c0 + n] * qs : 0.f; }
    LDS_WAIT(); asm volatile("" ::: "memory");
    const int c = lane & 7;
#pragma unroll
    for (int j = 0; j < 4; ++j) { const int n = (lane >> 3) + 8 * j; const LAS float* sp = scr + (8 * c) * 33 + n;
        v2u o; o.x = pk4_i8(sp[0 * 33], sp[1 * 33], sp[2 * 33], sp[3 * 33]); o.y = pk4_i8(sp[4 * 33], sp[5 * 33], sp[6 * 33], sp[7 * 33]);
        *(GAS v2u*)(WT8 + (size_t)(drow0 + n) * ldk + k0 + 8 * c) = o; }
    LDS_WAIT(); asm volatile("" ::: "memory");
}
template <bool I8 = false>
__device__ __forceinline__ void normmod_phase(const float* xin, const float* g, const float* sh, const float* sc, bf16* xo, float* rsc, int gw, int NGW, int lane) {
    for (int row0 = gw * 32; row0 < M; row0 += NGW * 32) {
        const int b = row0 >> 11;
        f32x4 A[4], Bv[4];
#pragma unroll
        for (int j = 0; j < 4; ++j) { const int col = 4 * lane + 256 * j; const f32x4 gv = *(const f32x4*)(g + col), sv = *(const f32x4*)(sc + (size_t)b * MODW + col); A[j] = gv * (sv + 1.0f); Bv[j] = *(const f32x4*)(sh + (size_t)b * MODW + col); }
        for (int rr = 0; rr < 32; rr += 4) {
            f32x4 v[4][4]; float s[4];
#pragma unroll
            for (int q = 0; q < 4; ++q) { const GAS f32x4* xr = (const GAS f32x4*)(xin + (size_t)(row0 + rr + q) * D) + lane;
#pragma unroll
                for (int j = 0; j < 4; ++j) v[q][j] = xr[64 * j]; }
#pragma unroll
            for (int q = 0; q < 4; ++q) { float t = 0.f;
#pragma unroll
                for (int j = 0; j < 4; ++j) t += (v[q][j].x * v[q][j].x + v[q][j].y * v[q][j].y) + (v[q][j].z * v[q][j].z + v[q][j].w * v[q][j].w);
                s[q] = t; }
#pragma unroll
            for (int o = 1; o < 64; o <<= 1) {
#pragma unroll
                for (int q = 0; q < 4; ++q) s[q] += __shfl_xor(s[q], o); }
#pragma unroll
            for (int q = 0; q < 4; ++q) { const float rs = __builtin_amdgcn_rsqf(s[q] * (1.0f / D) + EPS);
#pragma unroll
                for (int j = 0; j < 4; ++j) v[q][j] = v[q][j] * rs * A[j] + Bv[j]; }
            if (I8) {
                float mx[4];
#pragma unroll
                for (int q = 0; q < 4; ++q) { float t = 0.f;
#pragma unroll
                    for (int j = 0; j < 4; ++j) t = fmaxf(fmaxf(t, fmaxf(fabsf(v[q][j].x), fabsf(v[q][j].y))), fmaxf(fabsf(v[q][j].z), fabsf(v[q][j].w)));
                    mx[q] = t; }
#pragma unroll
                for (int o = 1; o < 64; o <<= 1) {
#pragma unroll
                    for (int q = 0; q < 4; ++q) mx[q] = fmaxf(mx[q], __shfl_xor(mx[q], o)); }
#pragma unroll
                for (int q = 0; q < 4; ++q) { const float qs = mx[q] > 0.f ? 127.0f / mx[q] : 0.f;
                    GAS unsigned* o4 = (GAS unsigned*)((unsigned char*)xo + (size_t)(row0 + rr + q) * D) + lane;
#pragma unroll
                    for (int j = 0; j < 4; ++j) o4[64 * j] = pk4_i8(v[q][j].x * qs, v[q][j].y * qs, v[q][j].z * qs, v[q][j].w * qs);
                    if (lane == 0) rsc[row0 + rr + q] = mx[q] * (1.0f / 127.0f); }
            } else {
#pragma unroll
                for (int q = 0; q < 4; ++q) { GAS v2u* o8 = (GAS v2u*)(xo + (size_t)(row0 + rr + q) * D) + lane;
#pragma unroll
                    for (int j = 0; j < 4; ++j) { const f32x4 o = v[q][j]; v2u w; w.x = cvtpk(o.x, o.y); w.y = cvtpk(o.z, o.w); o8[64 * j] = w; } }
            }
        }
    }
}
template <bool I8 = false>
__device__ __forceinline__ void normmod_bf_phase(const bf16* xin, const float* g, const float* sh, const float* sc, bf16* xo, float* rsc, int gw, int NGW, int lane) {
    for (int row0 = gw * 32; row0 < M; row0 += NGW * 32) {
        const int b = row0 >> 11;
        f32x4 A[4], Bv[4];
#pragma unroll
        for (int j = 0; j < 4; ++j) { const int col = 4 * lane + 256 * j; const f32x4 gv = *(const f32x4*)(g + col), sv = *(const f32x4*)(sc + (size_t)b * MODW + col); A[j] = gv * (sv + 1.0f); Bv[j] = *(const f32x4*)(sh + (size_t)b * MODW + col); }
        for (int rr = 0; rr < 32; rr += 4) {
            v2u w[4][4]; float s[4];
#pragma unroll
            for (int q = 0; q < 4; ++q) { const GAS v2u* xr = (const GAS v2u*)(xin + (size_t)(row0 + rr + q) * D) + lane;
#pragma unroll
                for (int j = 0; j < 4; ++j) w[q][j] = xr[64 * j]; }
#pragma unroll
            for (int q = 0; q < 4; ++q) { float t = 0.f;
#pragma unroll
                for (int j = 0; j < 4; ++j) { const float a0 = wlo(w[q][j].x), a1 = whi(w[q][j].x), a2 = wlo(w[q][j].y), a3 = whi(w[q][j].y); t += (a0 * a0 + a1 * a1) + (a2 * a2 + a3 * a3); }
                s[q] = t; }
#pragma unroll
            for (int o = 1; o < 64; o <<= 1) {
#pragma unroll
                for (int q = 0; q < 4; ++q) s[q] += __shfl_xor(s[q], o); }
            f32x4 v[4][4];
#pragma unroll
            for (int q = 0; q < 4; ++q) { const float rs = __builtin_amdgcn_rsqf(s[q] * (1.0f / D) + EPS);
#pragma unroll
                for (int j = 0; j < 4; ++j) v[q][j] = (f32x4){wlo(w[q][j].x), whi(w[q][j].x), wlo(w[q][j].y), whi(w[q][j].y)} * rs * A[j] + Bv[j]; }
            if (I8) {
                float mx[4];
#pragma unroll
                for (int q = 0; q < 4; ++q) { float t = 0.f;
#pragma unroll
                    for (int j = 0; j < 4; ++j) t = fmaxf(fmaxf(t, fmaxf(fabsf(v[q][j].x), fabsf(v[q][j].y))), fmaxf(fabsf(v[q][j].z), fabsf(v[q][j].w)));
                    mx[q] = t; }
#pragma unroll
                for (int o = 1; o < 64; o <<= 1) {
#pragma unroll
                    for (int q = 0; q < 4; ++q) mx[q] = fmaxf(mx[q], __shfl_xor(mx[q], o)); }
#pragma unroll
                for (int q = 0; q < 4; ++q) { const float qs = mx[q] > 0.f ? 127.0f / mx[q] : 0.f;
                    GAS unsigned* o4 = (GAS unsigned*)((unsigned char*)xo + (size_t)(row0 + rr + q) * D) + lane;
#pragma unroll
                    for (int j = 0; j < 4; ++j) o4[64 * j] = pk4_i8(v[q][j].x * qs, v[q][j].y * qs, v[q][j].z * qs, v[q][j].w * qs);
                    if (lane == 0) rsc[row0 + rr + q] = mx[q] * (1.0f / 127.0f); }
            } else {
#pragma unroll
                for (int q = 0; q < 4; ++q) { GAS v2u* o8 = (GAS v2u*)(xo + (size_t)(row0 + rr + q) * D) + lane;
#pragma unroll
                    for (int j = 0; j < 4; ++j) { const f32x4 o = v[q][j]; v2u ww; ww.x = cvtpk(o.x, o.y); ww.y = cvtpk(o.z, o.w); o8[64 * j] = ww; } }
            }
        }
    }
}
__device__ __forceinline__ void finalnorm_phase(const bf16* xin, const float* g, float* out, int gw, int NGW, int lane) {
    f32x4 A[4];
#pragma unroll
    for (int j = 0; j < 4; ++j) A[j] = *(const f32x4*)(g + 4 * lane + 256 * j);
    for (int row0 = 4 * gw; row0 < M; row0 += 4 * NGW) {
        v2u w[4][4]; float s[4];
#pragma unroll
        for (int q = 0; q < 4; ++q) { const GAS v2u* xr = (const GAS v2u*)(xin + (size_t)(row0 + q) * D) + lane;
#pragma unroll
            for (int j = 0; j < 4; ++j) w[q][j] = xr[64 * j]; }
#pragma unroll
        for (int q = 0; q < 4; ++q) { float t = 0.f;
#pragma unroll
            for (int j = 0; j < 4; ++j) { const float a0 = wlo(w[q][j].x), a1 = whi(w[q][j].x), a2 = wlo(w[q][j].y), a3 = whi(w[q][j].y); t += (a0 * a0 + a1 * a1) + (a2 * a2 + a3 * a3); }
            s[q] = t; }
#pragma unroll
        for (int o = 1; o < 64; o <<= 1) {
#pragma unroll
            for (int q = 0; q < 4; ++q) s[q] += __shfl_xor(s[q], o); }
#pragma unroll
        for (int q = 0; q < 4; ++q) { const float rs = __builtin_amdgcn_rsqf(s[q] * (1.0f / D) + EPS);
            GAS f32x4* orow = (GAS f32x4*)(out + (size_t)(row0 + q) * D) + lane;
#pragma unroll
            for (int j = 0; j < 4; ++j) { const f32x4 v = (f32x4){wlo(w[q][j].x), whi(w[q][j].x), wlo(w[q][j].y), whi(w[q][j].y)}; orow[64 * j] = v * rs * A[j]; } }
    }
}
__device__ __forceinline__ void uquant_phase(const bf16* U, unsigned char* U8, float* rsc, int gw, int NGW, int lane) {
    for (int row0 = 2 * gw; row0 < M; row0 += 2 * NGW) {
        v2u w[2][11]; float mx[2];
#pragma unroll
        for (int q = 0; q < 2; ++q) { const GAS v2u* ur = (const GAS v2u*)(U + (size_t)(row0 + q) * FF) + lane;
#pragma unroll
            for (int j = 0; j < 11; ++j) w[q][j] = ur[64 * j]; }
#pragma unroll
        for (int q = 0; q < 2; ++q) { float t = 0.f;
#pragma unroll
            for (int j = 0; j < 11; ++j) t = fmaxf(fmaxf(t, fmaxf(fabsf(wlo(w[q][j].x)), fabsf(whi(w[q][j].x)))), fmaxf(fabsf(wlo(w[q][j].y)), fabsf(whi(w[q][j].y))));
            mx[q] = t; }
#pragma unroll
        for (int o = 1; o < 64; o <<= 1) { mx[0] = fmaxf(mx[0], __shfl_xor(mx[0], o)); mx[1] = fmaxf(mx[1], __shfl_xor(mx[1], o)); }
#pragma unroll
        for (int q = 0; q < 2; ++q) { const float qs = mx[q] > 0.f ? 127.0f / mx[q] : 0.f;
            GAS unsigned* o4 = (GAS unsigned*)(U8 + (size_t)(row0 + q) * FF) + lane;
#pragma unroll
            for (int j = 0; j < 11; ++j) o4[64 * j] = pk4_i8(wlo(w[q][j].x) * qs, whi(w[q][j].x) * qs, wlo(w[q][j].y) * qs, whi(w[q][j].y) * qs);
            if (lane == 0) rsc[row0 + q] = mx[q] * (1.0f / 127.0f); }
    }
}
__device__ __forceinline__ void smallnorm_phase(const bf16* P, const float* g_cq, const float* g_ckv, const float* g_kidx, const float* b_kidx,
                                                bf16* CQN, bf16* CKVN, bf16* KIDXN, float* WIDX, int gw, int NGW, int lane) {
    const f32x4 gq = *(const f32x4*)(g_cq + 4 * lane);
    const float gk0 = g_ckv[2 * lane], gk1 = g_ckv[2 * lane + 1], gi = g_kidx[lane], bi = b_kidx[lane];
    for (int row0 = 4 * gw; row0 < M; row0 += 4 * NGW) {
        v2u wq[4]; unsigned wk[4]; bf16 wi[4]; bf16 ww[4];
#pragma unroll
        for (int q = 0; q < 4; ++q) { const bf16* pr = P + (size_t)(row0 + q) * PW;
            wq[q] = *(const v2u*)(pr + PC_CQ + 4 * lane); wk[q] = *(const unsigned*)(pr + PC_CKV + 2 * lane); wi[q] = pr[PC_KIDX + lane]; ww[q] = pr[PC_WIDX + (lane & 3)]; }
        float sq[4], sk[4], si[4];
#pragma unroll
        for (int q = 0; q < 4; ++q) { const float q0 = wlo(wq[q].x), q1 = whi(wq[q].x), q2 = wlo(wq[q].y), q3 = whi(wq[q].y), k0 = wlo(wk[q]), k1 = whi(wk[q]);
            sq[q] = (q0 * q0 + q1 * q1) + (q2 * q2 + q3 * q3); sk[q] = k0 * k0 + k1 * k1; si[q] = bf2f(wi[q]); }
#pragma unroll
        for (int o = 1; o < 64; o <<= 1) {
#pragma unroll
            for (int q = 0; q < 4; ++q) { sq[q] += __shfl_xor(sq[q], o); sk[q] += __shfl_xor(sk[q], o); si[q] += __shfl_xor(si[q], o); } }
        float xc[4], sv[4];
#pragma unroll
        for (int q = 0; q < 4; ++q) { xc[q] = bf2f(wi[q]) - si[q] * (1.0f / 64.0f); sv[q] = xc[q] * xc[q]; }
#pragma unroll
        for (int o = 1; o < 64; o <<= 1) {
#pragma unroll
            for (int q = 0; q < 4; ++q) sv[q] += __shfl_xor(sv[q], o); }
#pragma unroll
        for (int q = 0; q < 4; ++q) { const size_t row = (size_t)(row0 + q);
            const float rq = __builtin_amdgcn_rsqf(sq[q] * (1.0f / 256.0f) + EPS), rk = __builtin_amdgcn_rsqf(sk[q] * (1.0f / 128.0f) + EPS), ri = __builtin_amdgcn_rsqf(sv[q] * (1.0f / 64.0f) + EPS);
            const float q0 = wlo(wq[q].x), q1 = whi(wq[q].x), q2 = wlo(wq[q].y), q3 = whi(wq[q].y), k0 = wlo(wk[q]), k1 = whi(wk[q]);
            v2u oq; oq.x = cvtpk(q0 * rq * gq.x, q1 * rq * gq.y); oq.y = cvtpk(q2 * rq * gq.z, q3 * rq * gq.w);
            *(v2u*)(CQN + row * 256 + 4 * lane) = oq;
            *(unsigned*)(CKVN + row * 128 + 2 * lane) = cvtpk(k0 * rk * gk0, k1 * rk * gk1);
            KIDXN[row * 64 + lane] = (bf16)(cvtpk(xc[q] * ri * gi + bi, 0.f) & 0xffffu);
            if (lane < 4) WIDX[row * 4 + lane] = bf2f(ww[q]) * 0.0625f; }
    }
}

#define MFMA32(a, b, c) __builtin_amdgcn_mfma_f32_32x32x16_bf16((a), (b), (c), 0, 0, 0)
__device__ __forceinline__ s16x4 vtr(const LAS unsigned char* p) { return __builtin_bit_cast(s16x4, __builtin_amdgcn_ds_read_tr16_b64_v4i16((LAS v4i16_t*)p)); }
__device__ __forceinline__ unsigned off_b(unsigned row, unsigned ch) { return 256u * row + 16u * (ch ^ (((row & 3u) << 2) | ((row >> 2) & 3u))); }
__device__ __forceinline__ unsigned ord_key(float s) { unsigned b = __float_as_uint(s); if (b == 0x80000000u) b = 0u; return b ^ ((b >> 31) ? 0xFFFFFFFFu : 0x80000000u); }
__device__ __forceinline__ bf16x8 pack8(const f32x16& x, int s) {
    v4u w; w.x = cvtpk(x[8 * s], x[8 * s + 1]); w.y = cvtpk(x[8 * s + 2], x[8 * s + 3]); w.z = cvtpk(x[8 * s + 4], x[8 * s + 5]); w.w = cvtpk(x[8 * s + 6], x[8 * s + 7]);
    return __builtin_bit_cast(bf16x8, w);
}
__device__ __forceinline__ unsigned wave_prefix_incl(unsigned x, int lane) {
    x += (unsigned)__builtin_amdgcn_update_dpp(0, (int)x, 0x111, 0xf, 0xf, true);
    x += (unsigned)__builtin_amdgcn_update_dpp(0, (int)x, 0x112, 0xf, 0xf, true);
    x += (unsigned)__builtin_amdgcn_update_dpp(0, (int)x, 0x114, 0xf, 0xf, true);
    x += (unsigned)__builtin_amdgcn_update_dpp(0, (int)x, 0x118, 0xf, 0xf, true);
    const unsigned t0 = (unsigned)__builtin_amdgcn_readlane((int)x, 15), t1 = (unsigned)__builtin_amdgcn_readlane((int)x, 31), t2 = (unsigned)__builtin_amdgcn_readlane((int)x, 47);
    const int row = lane >> 4;
    return x + (row >= 1 ? t0 : 0u) + (row >= 2 ? t1 : 0u) + (row >= 3 ? t2 : 0u);
}
constexpr int DSA_SC_OFF = 0, DSA_MASK_OFF = 131072, DSA_KT_OFF = 0;

__device__ __forceinline__ void dsa_select(LAS unsigned char* lds, int b, int qt, const bf16* QIDX, const bf16* KIDXN, const float* WIDX, unsigned* MASKG, int tid, int lane, int wave, int flags) {
    LAS float* SC = (LAS float*)(lds + DSA_SC_OFF);
    const int r = lane & 31, hh = lane >> 5;
    const size_t tokb = (size_t)b * SEQ;
    const int ntile = qt + 1;
    for (int p = 0; p < 2; ++p) {
        const int tq0 = 32 * qt + 16 * p;
        {
            bf16x8 Aq[2][4]; f32x4 wq[2][4];
#pragma unroll
            for (int rt = 0; rt < 2; ++rt) {
#pragma unroll
                for (int s = 0; s < 4; ++s) Aq[rt][s] = *(const bf16x8*)(QIDX + (tokb + tq0 + 8 * rt + (r >> 2)) * 256 + (r & 3) * 64 + 16 * s + 8 * hh);
#pragma unroll
                for (int g = 0; g < 4; ++g) wq[rt][g] = *(const f32x4*)(WIDX + (tokb + tq0 + 8 * rt + 2 * g + hh) * 4);
            }
            bf16x8 Bk[2][4], Bn[2][4];
#pragma unroll
            for (int tt = 0; tt < 2; ++tt) { const int T = wave + 8 * tt; if (T < ntile) {
#pragma unroll
                for (int s = 0; s < 4; ++s) Bk[tt][s] = *(const bf16x8*)(KIDXN + (tokb + 32 * T + r) * 64 + 16 * s + 8 * hh); } }
            for (int T0 = wave; T0 < ntile; T0 += 16) {
#pragma unroll
                for (int tt = 0; tt < 2; ++tt) { const int T = T0 + 16 + 8 * tt; if (T < ntile) {
#pragma unroll
                    for (int s = 0; s < 4; ++s) Bn[tt][s] = *(const bf16x8*)(KIDXN + (tokb + 32 * T + r) * 64 + 16 * s + 8 * hh); } }
#pragma unroll
                for (int tt = 0; tt < 2; ++tt) { const int T = T0 + 8 * tt; if (T < ntile) {
#pragma unroll
                    for (int rt = 0; rt < 2; ++rt) {
                        f32x16 acc;
#pragma unroll
                        for (int i = 0; i < 16; ++i) acc[i] = 0.f;
#pragma unroll
                        for (int s = 0; s < 4; ++s) acc = MFMA32(Aq[rt][s], Bk[tt][s], acc);
#pragma unroll
                        for (int g = 0; g < 4; ++g) {
                            const float sc = (fmaxf(acc[4 * g], 0.f) * wq[rt][g][0] + fmaxf(acc[4 * g + 1], 0.f) * wq[rt][g][1]) + (fmaxf(acc[4 * g + 2], 0.f) * wq[rt][g][2] + fmaxf(acc[4 * g + 3], 0.f) * wq[rt][g][3]);
                            SC[(8 * rt + 2 * g + hh) * 2048 + 32 * T + r] = sc + 0.0f;
                        }
                    } } }
#pragma unroll
                for (int tt = 0; tt < 2; ++tt)
#pragma unroll
                    for (int s = 0; s < 4; ++s) Bk[tt][s] = Bn[tt][s];
            }
        }
        __syncthreads();
        if (!(flags & 8)) {
            const int ta = tq0 + wave, tb = ta + 8;
            unsigned ka[32], kb[32];
#pragma unroll
            for (int i = 0; i < 32; ++i) { const unsigned ba = __float_as_uint(SC[wave * 2048 + lane + 64 * i]), bb = __float_as_uint(SC[(wave + 8) * 2048 + lane + 64 * i]);
                ka[i] = (ba ^ ((unsigned)((int)ba >> 31) | 0x80000000u)) >> 2; kb[i] = (bb ^ ((unsigned)((int)bb >> 31) | 0x80000000u)) >> 2; }
            { const int ia = ta >> 6, ib = tb >> 6;
#pragma unroll
              for (int g = 0; g < 8; ++g) {
                  if (4 * g + 3 >= ia) {
#pragma unroll
                      for (int i = 4 * g; i < 4 * g + 4; ++i) { if (i > ia) ka[i] = 0u; else if (i == ia) ka[i] = (lane <= ta - 64 * i) ? ka[i] : 0u; } }
                  if (4 * g + 3 >= ib) {
#pragma unroll
                      for (int i = 4 * g; i < 4 * g + 4; ++i) { if (i > ib) kb[i] = 0u; else if (i == ib) kb[i] = (lane <= tb - 64 * i) ? kb[i] : 0u; } }
              } }
            __syncthreads();
            LAS unsigned* H = (LAS unsigned*)lds + wave * 1024;
#pragma unroll
            for (int qi = 0; qi < 2; ++qi) {
                const int t = qi ? tb : ta;
                unsigned T = 1u; int sh = 0, need = 0; bool allties = true;
                if (t + 1 > 256) { allties = false;
                    const int ngrp = (t >> 8) + 1;
                    unsigned prefix = 0u; need = 256;
                    for (int rp = 0; rp < 3; ++rp) {
                        sh = 20 - 10 * rp;
#pragma unroll
                        for (int j = 0; j < 4; ++j) *(LAS v4u*)(H + 16 * lane + 4 * j) = (v4u){0u, 0u, 0u, 0u};
#pragma unroll
                        for (int g = 0; g < 8; ++g) if (g < ngrp) {
#pragma unroll
                            for (int i = 4 * g; i < 4 * g + 4; ++i) { const unsigned kk = qi ? kb[i] : ka[i]; const unsigned d = (kk >> sh) & 1023u;
                                if (rp == 0) __hip_atomic_fetch_add(H + d, 1u, __ATOMIC_RELAXED, __HIP_MEMORY_SCOPE_WORKGROUP);
                                else __hip_atomic_fetch_add(H + d, ((kk >> (sh + 10)) == prefix) ? 1u : 0u, __ATOMIC_RELAXED, __HIP_MEMORY_SCOPE_WORKGROUP); }
                        }
                        unsigned c[16];
#pragma unroll
                        for (int j = 0; j < 4; ++j) { const v4u hv = *(const LAS v4u*)(H + 16 * lane + 4 * j); c[4 * j] = hv.x; c[4 * j + 1] = hv.y; c[4 * j + 2] = hv.z; c[4 * j + 3] = hv.w; }
                        unsigned sl = 0u;
#pragma unroll
                        for (int j = 0; j < 16; ++j) sl += c[j];
                        const unsigned pin = wave_prefix_incl(sl, lane);
                        const unsigned S = (unsigned)__builtin_amdgcn_readlane((int)pin, 63) - pin;
                        const bool hit = ((int)S < need) && ((int)(S + sl) >= need);
                        unsigned run = S; int fbin = 0; unsigned fab = 0u, fin = 0u; bool found = false;
#pragma unroll
                        for (int j = 15; j >= 0; --j) { const bool here = !found && ((int)(run + c[j]) >= need); fbin = here ? j : fbin; fab = here ? run : fab; fin = here ? c[j] : fin; found = found || here; run += c[j]; }
                        const int hl = __ffsll((unsigned long long)__ballot(hit)) - 1;
                        const unsigned bin = (unsigned)__builtin_amdgcn_readlane(16 * lane + fbin, hl), above = (unsigned)__builtin_amdgcn_readlane((int)fab, hl), inb = (unsigned)__builtin_amdgcn_readlane((int)fin, hl);
                        prefix = (prefix << 10) | bin; need -= (int)above;
                        if ((int)inb == need) { allties = true; break; }
                    }
                    T = prefix;
                }
                unsigned mlo = 0u, mhi = 0u;
                if (allties) {
#pragma unroll
                    for (int i = 0; i < 32; ++i) { const unsigned long long sel = __ballot(((qi ? kb[i] : ka[i]) >> sh) >= T);
                        asm volatile("s_nop 3\n\tv_writelane_b32 %0, %2, %4\n\tv_writelane_b32 %1, %3, %4" : "+v"(mlo), "+v"(mhi) : "s"((unsigned)sel), "s"((unsigned)(sel >> 32)), "n"(i)); }
                } else {
                    int runt = 0;
#pragma unroll
                    for (int i = 0; i < 32; ++i) {
                        const unsigned kk = (qi ? kb[i] : ka[i]) >> sh;
                        const bool tie = (kk == T); const unsigned long long tm = __ballot(tie);
                        const int below = (int)__builtin_amdgcn_mbcnt_hi((unsigned)(tm >> 32), __builtin_amdgcn_mbcnt_lo((unsigned)tm, 0u));
                        const unsigned long long sel = __ballot((kk > T) || (tie && (runt + below < need)));
                        runt += __popcll(tm);
                        asm volatile("s_nop 3\n\tv_writelane_b32 %0, %2, %4\n\tv_writelane_b32 %1, %3, %4" : "+v"(mlo), "+v"(mhi) : "s"((unsigned)sel), "s"((unsigned)(sel >> 32)), "n"(i));
                    }
                }
                if (lane < 32) { v2u mv; mv.x = mlo; mv.y = mhi; *(v2u*)(MASKG + (tokb + tq0 + wave + 8 * qi) * 64 + 2 * lane) = mv; }
            }
        }
        __syncthreads();
    }
}

__device__ __forceinline__ float halfmax(float v) {
    auto rr = __builtin_amdgcn_permlane32_swap(__float_as_uint(v), __float_as_uint(v), false, false);
    return fmaxf(__uint_as_float(rr[0]), __uint_as_float(rr[1]));
}
__device__ __forceinline__ float max16(const f32x16& p) {
    float a = fmaxf(fmaxf(p[0], p[1]), p[2]), b = fmaxf(fmaxf(p[3], p[4]), p[5]);
    a = fmaxf(fmaxf(a, p[6]), p[7]); b = fmaxf(fmaxf(b, p[8]), p[9]); a = fmaxf(fmaxf(a, p[10]), p[11]); b = fmaxf(fmaxf(b, p[12]), p[13]);
    return fmaxf(fmaxf(a, b), fmaxf(p[14], p[15]));
}
__device__ __forceinline__ void dsa_attn(LAS unsigned char* lds, int b, int qt, const unsigned* MASKG, const bf16* QLAT, const bf16* CKVN, const bf16* WUVT, bf16* ODSA, int tid, int lane, int wave, int vflags) {
    LAS unsigned* MASK = (LAS unsigned*)(lds + DSA_MASK_OFF);
    const size_t tokb = (size_t)b * SEQ;
    { const v4u mv = *(const v4u*)(MASKG + (tokb + 32 * qt) * 64 + 4 * tid); *(LAS v4u*)(MASK + 4 * tid) = mv; }
    const int r = lane & 31, hh = lane >> 5;
    const int tq = 32 * qt + r; const size_t tok = tokb + tq;
    const int nT = (qt >> 1) + 1;
    bf16x8 Qf[8];
#pragma unroll
    for (int s = 0; s < 8; ++s) Qf[s] = *(const bf16x8*)(QLAT + tok * 1024 + wave * 128 + 16 * s + 8 * hh);
    f32x16 O[4];
#pragma unroll
    for (int ct = 0; ct < 4; ++ct)
#pragma unroll
        for (int i = 0; i < 16; ++i) O[ct][i] = 0.f;
    float m = 0.f, l = 0.f; bool started = false;
    const float slope2 = __builtin_amdgcn_exp2f(-(float)(wave + 1)) * LOG2E;
    const int srow = tid >> 4, sch = tid & 15;
    const unsigned so0 = off_b(srow, sch), so1 = off_b(srow + 32, sch);
    const bf16* gsrc = CKVN + (tokb + srow) * 128 + sch * 8;
    const unsigned xr = ((r & 3u) << 2) | ((r >> 2) & 3u);
    const int q4 = (lane & 15) >> 2, p4 = lane & 3, b16 = (lane >> 4) & 1;
    v4u sa, sb;
#define DA_LOADT(tt) { sa = *(const v4u*)(gsrc + (size_t)(tt) * 8192); sb = *(const v4u*)(gsrc + (size_t)(tt) * 8192 + 4096); }
#define DA_WRITET(bo) { *(LAS v4u*)(lds + (bo) + so0) = sa; *(LAS v4u*)(lds + (bo) + so1) = sb; }
#define DA_KREAD(hf, bo, s0) { const LAS unsigned char* kt_ = lds + (bo) + 8192 * (hf); \
        _Pragma("unroll") for (int s = 0; s < 4; ++s) kf[s] = *(const LAS bf16x8*)(kt_ + 256u * r + 16u * ((unsigned)(2 * ((s0) + s) + hh) ^ xr)); }
#define DA_INIT(tt, hf, P) { const float fb_ = -slope2 * (float)(tq - 64 * (tt) - 32 * (hf) - 4 * hh) - m; \
        const int m_ = (int)(MASK[r * 64 + 2 * (tt) + (hf)] >> (4 * hh)); \
        _Pragma("unroll") for (int i = 0; i < 16; ++i) { const int cr = (i & 3) + 8 * (i >> 2); const unsigned k_ = (unsigned)__builtin_amdgcn_sbfe(m_, cr, 1); \
            P[i] = __uint_as_float((__float_as_uint(fb_ + slope2 * (float)cr) & k_) | (0xFF800000u & ~k_)); } }
#define DA_SMMA(P, s0) { _Pragma("unroll") for (int s = 0; s < 4; ++s) P = MFMA32(kf[s], Qf[(s0) + s], P); }
#define DA_SOFT(P) { const float tmax_ = halfmax(max16(P)); const bool fresh_ = !started && (tmax_ > -INFINITY); \
        if (__any(fresh_ || (tmax_ > 8.0f))) { const float d_ = fresh_ ? tmax_ : fmaxf(tmax_, 0.f), alpha_ = fresh_ ? 1.0f : __builtin_amdgcn_exp2f(-d_); m += d_; l *= alpha_; \
            _Pragma("unroll") for (int ct = 0; ct < 4; ++ct) O[ct] = O[ct] * alpha_; \
            _Pragma("unroll") for (int i = 0; i < 16; ++i) P[i] -= d_; } \
        started = started || (tmax_ > -INFINITY); \
        float ls_ = 0.f; \
        _Pragma("unroll") for (int i = 0; i < 16; ++i) { const float e_ = __builtin_amdgcn_exp2f(P[i]); P[i] = e_; ls_ += e_; } \
        l += ls_; pf[0] = pack8(P, 0); pf[1] = pack8(P, 1); }
#define DA_VREAD(hf, bo, ks) { const LAS unsigned char* vt_ = lds + (bo) + 8192 * (hf); \
        _Pragma("unroll") for (int ct = 0; ct < 4; ++ct) { \
            const s16x4 lo_ = vtr(vt_ + off_b(16 * (ks) + 4 * hh + q4, 4 * ct + 2 * b16 + (p4 >> 1)) + 8 * (p4 & 1)); \
            const s16x4 hi_ = vtr(vt_ + off_b(16 * (ks) + 8 + 4 * hh + q4, 4 * ct + 2 * b16 + (p4 >> 1)) + 8 * (p4 & 1)); \
            vf[ct] = (bf16x8){lo_[0], lo_[1], lo_[2], lo_[3], hi_[0], hi_[1], hi_[2], hi_[3]}; } }
#define DA_PVMMA(ks) { _Pragma("unroll") for (int ct = 0; ct < 4; ++ct) O[ct] = MFMA32(vf[ct], pf[ks], O[ct]); }
#define DA_SB() __builtin_amdgcn_sched_barrier(0)
    bf16x8 kf[4], vf[4], pf[2];
    DA_LOADT(0) DA_WRITET(0)
    if (nT > 1) DA_LOADT(1)
    f32x16 pA;
#define DA_TILE(t, oP, oW) { \
        __syncthreads();                                              \
        if ((t) + 1 < nT) { DA_WRITET(oW) if ((t) + 2 < nT) DA_LOADT((t) + 2) } \
        _Pragma("unroll") for (int hf = 0; hf < 2; ++hf) { \
            if (!(vflags & 128)) DA_KREAD(hf, oP, 0) \
            if (!(vflags & 256)) DA_INIT(t, hf, pA) else { _Pragma("unroll") for (int i = 0; i < 16; ++i) pA[i] = 0.f; } \
            DA_SB(); if (!(vflags & 128)) { DA_SMMA(pA, 0) DA_KREAD(hf, oP, 4) DA_SB(); DA_SMMA(pA, 4) } \
            if (!(vflags & 32)) DA_SOFT(pA) else { pf[0] = pack8(pA, 0); pf[1] = pack8(pA, 1); } \
            if (!(vflags & 64)) { DA_VREAD(hf, oP, 0) DA_SB(); DA_PVMMA(0) DA_VREAD(hf, oP, 1) DA_SB(); DA_PVMMA(1) } } }
    for (int t = 0; t < nT; t += 2) { DA_TILE(t, 0, 16384) if (t + 1 < nT) DA_TILE(t + 1, 16384, 0) }
#undef DA_TILE
#undef DA_KREAD
#undef DA_INIT
#undef DA_SMMA
#undef DA_SOFT
#undef DA_VREAD
#undef DA_PVMMA
#undef DA_SB
#undef DA_LOADT
#undef DA_WRITET
    l += __shfl_xor(l, 32);
    const float inv = 1.0f / l;
    f32x16 Y[2];
#pragma unroll
    for (int dt = 0; dt < 2; ++dt)
#pragma unroll
        for (int i = 0; i < 16; ++i) Y[dt][i] = 0.f;
    int woff = (wave * 64 + r) * 128 + 4 * hh; asm volatile("" : "+v"(woff));
    const bf16* wrow = WUVT + woff;
#pragma unroll
    for (int ct = 0; ct < 4; ++ct)
#pragma unroll
        for (int sx = 0; sx < 2; ++sx) {
            const bf16x8 of = pack8(O[ct], sx);
#pragma unroll
            for (int dt = 0; dt < 2; ++dt) {
                const v2u lo = *(const v2u*)(wrow + (size_t)dt * 32 * 128 + 32 * ct + 16 * sx), hi = *(const v2u*)(wrow + (size_t)dt * 32 * 128 + 32 * ct + 16 * sx + 8);
                v4u aw; aw.x = lo.x; aw.y = lo.y; aw.z = hi.x; aw.w = hi.y;
                Y[dt] = MFMA32(__builtin_bit_cast(bf16x8, aw), of, Y[dt]);
            }
        }
    bf16* orow = ODSA + tok * 512 + wave * 64;
#pragma unroll
    for (int dt = 0; dt < 2; ++dt)
#pragma unroll
        for (int g = 0; g < 4; ++g) {
            v2u w; w.x = cvtpk(Y[dt][4 * g] * inv, Y[dt][4 * g + 1] * inv); w.y = cvtpk(Y[dt][4 * g + 2] * inv, Y[dt][4 * g + 3] * inv);
            *(v2u*)(orow + 32 * dt + 8 * g + 4 * hh) = w;
        }
    __syncthreads();
}

__device__ __forceinline__ void kmean_phase(LAS unsigned char* lds, const bf16* P, float* KMG, int bx, int G, int tid) {
    LAS float* PART = (LAS float*)lds;
    for (int bn = bx; bn < BATCH * 8; bn += G) {
        const int rg = tid >> 7, c4 = (tid & 127) * 4;
        const bf16* src = P + ((size_t)bn * 256 + 64 * rg) * PW + PC_MK + c4;
        float a0 = 0.f, a1 = 0.f, a2 = 0.f, a3 = 0.f;
        for (int r0 = 0; r0 < 64; r0 += 16) {
            v2u w[16];
#pragma unroll
            for (int i = 0; i < 16; ++i) w[i] = *(const v2u*)(src + (size_t)(r0 + i) * PW);
#pragma unroll
            for (int i = 0; i < 16; ++i) { a0 += wlo(w[i].x); a1 += whi(w[i].x); a2 += wlo(w[i].y); a3 += whi(w[i].y); }
        }
        *(LAS f32x4*)(PART + rg * 512 + c4) = (f32x4){a0, a1, a2, a3};
        __syncthreads();
        { const float t = (PART[tid] + PART[512 + tid]) + (PART[1024 + tid] + PART[1536 + tid]); KMG[(size_t)bn * 512 + tid] = t * (1.0f / 256.0f); }
        __syncthreads();
    }
}

__device__ __forceinline__ void moba_bh(LAS unsigned char* lds, int b, int h, const bf16* P, const float* KMG, bf16* OM, int tid, int lane, int wave, int vflags) {
    LAS float* KM = (LAS float*)(lds);
    LAS unsigned char* QS = (LAS unsigned char*)(lds + 2048);
    constexpr int KOFF = 24576, VOFF = 40960;
    const int r = lane & 31, hh = lane >> 5;
    const size_t tokb = (size_t)b * SEQ;
    const bf16* MQ = P + PC_MQ + h * 64; const bf16* MK = P + PC_MK + h * 64; const bf16* MV = P + PC_MV + h * 64;
    const float slope2 = __builtin_amdgcn_exp2f(-(float)(h + 1)) * LOG2E;
    const int q4 = (lane & 15) >> 2, p4 = lane & 3, b16 = (lane >> 4) & 1;
    const int srow = tid >> 3, sch = tid & 7;
    const unsigned kso = 128u * srow + 16u * (sch ^ ((srow >> 1) & 7)), vso = 128u * srow + 16u * (sch ^ (((srow >> 1) & 1) << 2));
    const unsigned kro = 128u * r, kx = (r >> 1) & 7;
    KM[tid] = KMG[((size_t)b * 8 + (tid >> 6)) * 512 + h * 64 + (tid & 63)];
    __syncthreads();
#pragma unroll 1
    for (int qi = 0; qi < 4; ++qi) {
        const int qn = tid + 512 * qi, blkq = qn >> 8;
        unsigned taken = 0u;
        if (blkq > 0) {
            const bf16* qp = MQ + (tokb + qn) * PW;
            float q[64];
#pragma unroll
            for (int c = 0; c < 8; ++c) { const v4u w = *(const v4u*)(qp + 8 * c); q[8 * c] = wlo(w.x); q[8 * c + 1] = whi(w.x); q[8 * c + 2] = wlo(w.y); q[8 * c + 3] = whi(w.y); q[8 * c + 4] = wlo(w.z); q[8 * c + 5] = whi(w.z); q[8 * c + 6] = wlo(w.w); q[8 * c + 7] = whi(w.w); }
            float gate[7];
#pragma unroll
            for (int n = 0; n < 7; ++n) { float a = 0.f;
#pragma unroll
                for (int d = 0; d < 64; ++d) a += q[d] * KM[n * 64 + d];
                gate[n] = (n < blkq) ? a : -INFINITY; }
#pragma unroll
            for (int pick = 0; pick < 3; ++pick) { float bv = -INFINITY; int best = -1;
#pragma unroll
                for (int n = 0; n < 7; ++n) { const bool ok = !((taken >> n) & 1u) && gate[n] > bv; bv = ok ? gate[n] : bv; best = ok ? n : best; }
                if (best >= 0) taken |= 1u << best; }
        }
        QS[qn] = (unsigned char)taken;
    }
    __syncthreads();
    bf16x8 Qf[4];
    const bf16* ksrc = MK + (tokb + srow) * PW + sch * 8; const bf16* vsrc = MV + (tokb + srow) * PW + sch * 8;
    v4u sk = *(const v4u*)ksrc, sv = *(const v4u*)vsrc;
#pragma unroll
    for (int s = 0; s < 4; ++s) Qf[s] = *(const bf16x8*)(MQ + (tokb + 32 * wave + r) * PW + 16 * s + 8 * hh);
    for (int blk = 0; blk < 8; ++blk) {
        const int tq = 256 * blk + 32 * wave + r; const size_t tok = tokb + tq;
        const unsigned selq = QS[tq];
        f32x16 O[2];
#pragma unroll
        for (int ct = 0; ct < 2; ++ct)
#pragma unroll
            for (int i = 0; i < 16; ++i) O[ct][i] = 0.f;
        float m = 0.f, l = 0.f;
        const int ntl = 4 * (blk + 1);
        bf16x8 kf[4], vf[4], pf[2]; f32x16 pa;
#define MB_HALF(gT, hf, bo) { const int j_ = (gT) >> 2, kh_ = 2 * ((gT) & 3) + (hf); \
            const bool own_ = (j_ == blk); const bool lsel_ = own_ ? true : (((selq >> j_) & 1u) != 0u); \
            const bool act_ = own_ ? (kh_ <= wave) : (__any(lsel_) != 0); \
            if (act_ && !(vflags & 512)) { const LAS unsigned char* kt_ = lds + KOFF + (bo) + 4096 * (hf); const LAS unsigned char* vt_ = lds + VOFF + (bo) + 4096 * (hf); \
                _Pragma("unroll") for (int s = 0; s < 4; ++s) kf[s] = *(const LAS bf16x8*)(kt_ + kro + 16u * ((unsigned)(2 * s + hh) ^ kx)); \
                const float fb_ = lsel_ ? (-slope2 * (float)(tq - 64 * (gT) - 32 * (hf) - 4 * hh) - m) : -INFINITY; \
                const bool diag_ = own_ && (kh_ == wave); \
                _Pragma("unroll") for (int i = 0; i < 16; ++i) { const int cr = (i & 3) + 8 * (i >> 2); pa[i] = fb_ + slope2 * (float)cr; } \
                if (diag_) { _Pragma("unroll") for (int i = 0; i < 16; ++i) { const int cr = (i & 3) + 8 * (i >> 2); pa[i] = (cr + 4 * hh <= r) ? pa[i] : -INFINITY; } } \
                _Pragma("unroll") for (int s = 0; s < 4; ++s) pa = MFMA32(kf[s], Qf[s], pa); \
                const float tmax_ = halfmax(max16(pa));                        \
                if (__any(tmax_ > 8.0f)) { const float d_ = fmaxf(tmax_, 0.f), alpha_ = __builtin_amdgcn_exp2f(-d_); m += d_; l *= alpha_; O[0] = O[0] * alpha_; O[1] = O[1] * alpha_; \
                    _Pragma("unroll") for (int i = 0; i < 16; ++i) pa[i] -= d_; } \
                float ls_ = 0.f; \
                _Pragma("unroll") for (int i = 0; i < 16; ++i) { const float e_ = __builtin_amdgcn_exp2f(pa[i]); pa[i] = e_; ls_ += e_; } \
                l += ls_; pf[0] = pack8(pa, 0); pf[1] = pack8(pa, 1); \
                _Pragma("unroll") for (int ks = 0; ks < 2; ++ks) _Pragma("unroll") for (int ct = 0; ct < 2; ++ct) { \
                    const unsigned r0_ = 16 * ks + 4 * hh + q4, r1_ = r0_ + 8, ch_ = 4 * ct + 2 * b16 + (p4 >> 1); \
                    const s16x4 lo_ = vtr(vt_ + 128u * r0_ + 16u * (ch_ ^ (((r0_ >> 1) & 1u) << 2)) + 8 * (p4 & 1)); \
                    const s16x4 hi_ = vtr(vt_ + 128u * r1_ + 16u * (ch_ ^ (((r1_ >> 1) & 1u) << 2)) + 8 * (p4 & 1)); \
                    vf[ks * 2 + ct] = (bf16x8){lo_[0], lo_[1], lo_[2], lo_[3], hi_[0], hi_[1], hi_[2], hi_[3]}; } \
                _Pragma("unroll") for (int ks = 0; ks < 2; ++ks) _Pragma("unroll") for (int ct = 0; ct < 2; ++ct) O[ct] = MFMA32(vf[ks * 2 + ct], pf[ks], O[ct]); } }
#define MB_TILE(gT, bo) { *(LAS v4u*)(lds + KOFF + (bo) + kso) = sk; *(LAS v4u*)(lds + VOFF + (bo) + vso) = sv; \
            __syncthreads(); \
            { const int nx_ = ((gT) + 1 < ntl) ? (gT) + 1 : 0; sk = *(const v4u*)(ksrc + (size_t)64 * nx_ * PW); sv = *(const v4u*)(vsrc + (size_t)64 * nx_ * PW); } \
            MB_HALF(gT, 0, bo) MB_HALF(gT, 1, bo) }
        for (int gT = 0; gT < ntl; gT += 2) { MB_TILE(gT, 0) MB_TILE(gT + 1, 8192) }
#undef MB_HALF
#undef MB_TILE
        l += __shfl_xor(l, 32);
        const float inv = 1.0f / l;
        if (blk < 7) {
#pragma unroll
            for (int s = 0; s < 4; ++s) Qf[s] = *(const bf16x8*)(MQ + (tok + 256) * PW + 16 * s + 8 * hh);
        }
        bf16* orow = OM + tok * 512 + h * 64;
#pragma unroll
        for (int ct = 0; ct < 2; ++ct)
#pragma unroll
            for (int g = 0; g < 4; ++g) {
                v2u w; w.x = cvtpk(O[ct][4 * g] * inv, O[ct][4 * g + 1] * inv); w.y = cvtpk(O[ct][4 * g + 2] * inv, O[ct][4 * g + 3] * inv);
                *(v2u*)(orow + 32 * ct + 8 * g + 4 * hh) = w;
            }
    }
    __syncthreads();
}

struct Args { const float* in[26]; float* out; unsigned char* ws; int ph_lo, ph_hi, flags, pad; };
__global__ void __launch_bounds__(NWAVES * 64, 2) mk_fwd(Args args) {
    extern __shared__ __attribute__((aligned(16))) unsigned char lds_raw[];
    LAS unsigned char* lds = (LAS unsigned char*)lds_raw;
    volatile LAS unsigned* MISC = (volatile LAS unsigned*)(lds + MISC_OFF);
    const int wave = __builtin_amdgcn_readfirstlane((int)threadIdx.x >> 6);
    const int G = gridDim.x, bx = blockIdx.x;
    const int gw = bx * NWAVES + wave, NGW = G * NWAVES;
    gu32* ctl = (gu32*)(args.ws + WS_CTL);
#define KA_LD(T, off) (*(T const __attribute__((address_space(4)))*)(ka_ + (off)))
#define DECL_PTRS \
    int lane_p_ = lane_id(); asm volatile("" : "+v"(lane_p_)); const int lane = lane_p_, tid = wave * 64 + lane_p_; (void)tid; \
    const __attribute__((address_space(4))) unsigned char* ka_ = (const __attribute__((address_space(4))) unsigned char*)__builtin_amdgcn_kernarg_segment_ptr(); asm volatile("" : "+s"(ka_)); \
    const float* x = KA_LD(const float*, 0); const float* cc = KA_LD(const float*, 8); const float* w_ada = KA_LD(const float*, 16); const float* b_ada = KA_LD(const float*, 24); \
    const float* g_ffn1 = KA_LD(const float*, 32); const float* w1a = KA_LD(const float*, 40); const float* w3a = KA_LD(const float*, 48); const float* w2a = KA_LD(const float*, 56); \
    const float* g_mix = KA_LD(const float*, 64); const float* w_in = KA_LD(const float*, 72); const float* g_cq = KA_LD(const float*, 80); const float* g_ckv = KA_LD(const float*, 88); \
    const float* g_kidx = KA_LD(const float*, 96); const float* b_kidx = KA_LD(const float*, 104); const float* w_uq = KA_LD(const float*, 112); const float* w_qidx = KA_LD(const float*, 120); \
    const float* w_uk = KA_LD(const float*, 128); const float* w_uv = KA_LD(const float*, 136); const float* w_pd = KA_LD(const float*, 144); const float* w_pm = KA_LD(const float*, 152); \
    const float* w_out = KA_LD(const float*, 160); const float* g_ffn2 = KA_LD(const float*, 168); const float* w1b = KA_LD(const float*, 176); const float* w3b = KA_LD(const float*, 184); \
    const float* w2b = KA_LD(const float*, 192); const float* g_final = KA_LD(const float*, 200); \
    float* out = KA_LD(float*, 208); unsigned char* ws = KA_LD(unsigned char*, 216); const int pflags = KA_LD(int, 232); \
    float* MODS = (float*)(ws + WS_MODS); \
    bf16 *WT1A = (bf16*)(ws + WS_WT1A), *W2TA = (bf16*)(ws + WS_W2TA), *WT1B = (bf16*)(ws + WS_WT1B), *W2TB = (bf16*)(ws + WS_W2TB), *WIN = (bf16*)(ws + WS_WIN), *WQ = (bf16*)(ws + WS_WQ), \
         *WPD = (bf16*)(ws + WS_WC), *WUVT = (bf16*)(ws + WS_WC + MiB), *WPM = (bf16*)(ws + WS_WPM), *WOUT = (bf16*)(ws + WS_WOUT); \
    bf16 *CQN = (bf16*)(ws + WS_CQN), *CKVN = (bf16*)(ws + WS_CKVN), *KIDXN = (bf16*)(ws + WS_KIDXN), *QIDX = (bf16*)(ws + WS_QIDX), *OMOBA = (bf16*)(ws + WS_OMOBA); \
    float* WIDX = (float*)(ws + WS_WIDX); \
    bf16 *XN = (bf16*)(ws + WS_XN), *QLAT = XN, *T1 = XN, *ODSA = (bf16*)(ws + WS_OLAT), *Y = XN  , *PB = (bf16*)(ws + WS_P), *U = PB; \
    unsigned *CMAXA = (unsigned*)(ws + 768 * 1024), *CMAXB = (unsigned*)(ws + 800 * 1024), *CMAXW = (unsigned*)(ws + 832 * 1024), *CMAXDA = (unsigned*)(ws + 864 * 1024), *CMAXDB = (unsigned*)(ws + 872 * 1024); unsigned char* U8 = ws + 814 * MiB; float* RSU = (float*)(ws + WS_MODS + 1792 * 1024); float* RS = (float*)(ws + WS_MODS + 1536 * 1024);     \
    bf16 *X1 = (bf16*)out, *X2 = (bf16*)out + (size_t)M * D, *X3 = XN;     \
    (void)x; (void)cc; (void)w_ada; (void)b_ada; (void)g_ffn1; (void)w1a; (void)w3a; (void)w2a; (void)g_mix; (void)w_in; (void)g_cq; (void)g_ckv; (void)g_kidx; (void)b_kidx; (void)w_uq; (void)w_qidx; (void)w_uk; (void)w_uv; \
    (void)w_pd; (void)w_pm; (void)w_out; (void)g_ffn2; (void)w1b; (void)w3b; (void)w2b; (void)g_final; (void)out; (void)pflags; (void)MODS; (void)WT1A; (void)W2TA; (void)WT1B; (void)W2TB; (void)WIN; (void)WQ; (void)WPD; (void)WUVT; (void)WPM; (void)WOUT; \
    (void)CQN; (void)CKVN; (void)KIDXN; (void)QIDX; (void)OMOBA; (void)WIDX; (void)XN; (void)QLAT; (void)T1; (void)ODSA; (void)Y; (void)PB; (void)U; (void)X1; (void)X2; (void)X3; (void)CMAXA; (void)CMAXB; (void)CMAXW; (void)CMAXDA; (void)CMAXDB; (void)U8; (void)RSU; (void)RS;

    for (int u = threadIdx.x; u < (LDS_BYTES - LDSCTL_OFF) / 4; u += NWAVES * 64) ((LAS unsigned*)(lds + LDSCTL_OFF))[u] = 0u;
    __syncthreads();
    XcdBarrier bar; bar.bar = (unsigned*)(ctl + CW_BAR); bar.x = 0; bar.st = nullptr;
    if (MK_ONE_LAUNCH) bar = xcd_barrier_post((unsigned*)(ctl + CW_BAR), MISC + 8);
    const int lo = args.ph_lo, hi = args.ph_hi;
#define IN(k) (lo <= (k) && (k) < hi)
#define SEAM(k) do { if (IN(k) && IN((k) + 1)) xcd_barrier(bar); } while (0)

    if (IN(0)) { DECL_PTRS
        LAS float* scr = (LAS float*)(lds + wave * 16384);
        int it = gw, base = 0;
#define JOB(Wp, Nsrc, col0, nvalid_, ntotal_, Kdim, WTp, ldk, rowexpr) { const int nb_ = (ntotal_) / 32, n_ = ((Kdim) / 64) * nb_; \
            for (; it < base + n_; it += NGW) { const int loc = it - base, kb = loc / nb_, n0 = (loc % nb_) * 32; const int nv = ((nvalid_) - n0) < 32 ? ((nvalid_) - n0) : 32; \
                tr_item(Wp, Nsrc, (col0) + n0, nv, kb * 64, WTp, ldk, (rowexpr), scr, lane, JOB_SCALE); } base += n_; }
#define JOB_SCALE 1.0f
#define JOBMAX(Wp, CMp, rowexpr) { const int nb_ = FF / 32, n_ = (D / 64) * nb_; \
            for (; it < base + n_; it += NGW) { const int loc = it - base, kb = loc / nb_, n0 = (loc % nb_) * 32; colmax_item(Wp, FF, n0, kb * 64, CMp, (rowexpr), lane); } base += n_; }
        JOBMAX(w1a, CMAXA, (n0 / 128) * 256 + (n0 % 128))
        JOBMAX(w3a, CMAXA, (n0 / 128) * 256 + 128 + (n0 % 128))
        JOBMAX(w1b, CMAXB, (n0 / 128) * 256 + (n0 % 128))
        JOBMAX(w3b, CMAXB, (n0 / 128) * 256 + 128 + (n0 % 128))
#undef JOBMAX
#define JOBMAX2(Wp, CMp) { const int nb_ = D / 32, n_ = (FF / 64) * nb_; \
            for (; it < base + n_; it += NGW) { const int loc = it - base, kb = loc / nb_, n0 = (loc % nb_) * 32; colmax_item(Wp, D, n0, kb * 64, CMp, n0, lane); } base += n_; }
        JOBMAX2(w2a, CMAXDA) JOBMAX2(w2b, CMAXDB)
#undef JOBMAX2
#define JOBMAXW(col0, nvalid_, ntotal_, drow0_) { const int nb_ = (ntotal_) / 32, n_ = (D / 64) * nb_; \
            for (; it < base + n_; it += NGW) { const int loc = it - base, kb = loc / nb_, n0 = (loc % nb_) * 32; const int nv = ((nvalid_) - n0) < 32 ? ((nvalid_) - n0) : 32; \
                colmax_item(w_in, INW, (col0) + n0, kb * 64, CMAXW, (drow0_) + n0, lane, nv); } base += n_; }
        JOBMAXW(0, 448, 448, 0) JOBMAXW(448, 4, 64, 448) JOBMAXW(452, 3584, 3584, 512)
#undef JOBMAXW
        JOB(w_qidx, 256, 0, 256, 256, 256, WQ, 256, 1024 + n0)
        JOB(w_pm, D, 0, D, D, 512, WPM, 512, n0)
        JOB(w_pd, D, 0, D, D, 512, WPD, 512, n0)
        JOB(w_out, D, 0, D, D, D, WOUT, D, n0)
#undef JOB
#undef JOB_SCALE
        for (; it < base + 512; it += NGW) {
            const int jq = it - base, hd = jq >> 6, rq = (jq >> 4) & 3, c0 = (jq & 15) * 8, rr = 64 * rq + lane;
            float av[64];
#pragma unroll
            for (int d4 = 0; d4 < 16; ++d4) { const f32x4 t = *(const f32x4*)(w_uq + (size_t)rr * 512 + hd * 64 + 4 * d4); av[4 * d4] = t.x; av[4 * d4 + 1] = t.y; av[4 * d4 + 2] = t.z; av[4 * d4 + 3] = t.w; }
            float bv[8];
#pragma unroll
            for (int cx = 0; cx < 8; ++cx) bv[cx] = w_uk[(size_t)(c0 + cx) * 512 + hd * 64 + lane];
#pragma unroll
            for (int cx = 0; cx < 8; ++cx) { float sacc = 0.f;
#pragma unroll
                for (int d = 0; d < 64; ++d) sacc += av[d] * __uint_as_float(__builtin_amdgcn_readlane(__float_as_uint(bv[cx]), d));
                WQ[(size_t)(hd * 128 + c0 + cx) * 256 + rr] = (bf16)f2bf(sacc * (0.125f * LOG2E)); }
        }
        base += 512;
        for (int o = bx * 512 + tid; o < 8 * 64 * 128; o += G * 512) { const int hd = o >> 13, d = (o >> 7) & 63, c = o & 127; WUVT[o] = (bf16)f2bf(w_uv[(size_t)c * 512 + hd * 64 + d]); }
        __syncthreads();
        for (int grp = bx; grp < MODW / 32; grp += G) {
            LAS float* CA = (LAS float*)lds;
            for (int e = tid; e < BATCH * D; e += 512) { const int bb = e >> 10, k = e & 1023; const float v = cc[e]; CA[k * 32 + bb] = v / (1.0f + __expf(-v)); }
            __syncthreads();
            const int col = 32 * grp + (lane & 31), kbase = 128 * wave + 64 * (lane >> 5);
            float acc[32];
#pragma unroll
            for (int bb = 0; bb < 32; ++bb) acc[bb] = 0.f;
            for (int kb = 0; kb < 64; kb += 16) {
                float wv[16];
#pragma unroll
                for (int u = 0; u < 16; ++u) wv[u] = w_ada[(size_t)(kbase + kb + u) * MODW + col];
#pragma unroll
                for (int u = 0; u < 16; ++u) {
#pragma unroll
                    for (int b4 = 0; b4 < 8; ++b4) { const f32x4 cv = *(const LAS f32x4*)(CA + (kbase + kb + u) * 32 + 4 * b4); acc[4 * b4] += cv.x * wv[u]; acc[4 * b4 + 1] += cv.y * wv[u]; acc[4 * b4 + 2] += cv.z * wv[u]; acc[4 * b4 + 3] += cv.w * wv[u]; }
                }
            }
            __syncthreads();
            LAS float* PART = (LAS float*)lds;
#pragma unroll
            for (int bb = 0; bb < 32; ++bb) { const float t = acc[bb] + __shfl_xor(acc[bb], 32); if (lane < 32) PART[(wave * 32 + bb) * 32 + lane] = t; }
            __syncthreads();
            for (int o = tid; o < 1024; o += 512) { const int bb = o >> 5, cl = o & 31; float t = b_ada[32 * grp + cl];
#pragma unroll
                for (int w8 = 0; w8 < 8; ++w8) t += PART[(w8 * 32 + bb) * 32 + cl];
                MODS[(size_t)bb * MODW + 32 * grp + cl] = t; }
            __syncthreads();
        }
    }
    SEAM(0);
    if (IN(1)) { DECL_PTRS
        { LAS float* scr = (LAS float*)(lds + wave * 16384); int it = gw, base = 0;
#define JOBQ(Wp, WTp, CMp, rowexpr) { const int nb_ = FF / 32, n_ = (D / 64) * nb_; \
            for (; it < base + n_; it += NGW) { const int loc = it - base, kb = loc / nb_, n0 = (loc % nb_) * 32; tr_item_q8(Wp, FF, n0, kb * 64, (unsigned char*)(WTp), D, (rowexpr), CMp, scr, lane); } base += n_; }
          JOBQ(w1a, WT1A, CMAXA, (n0 / 128) * 256 + (n0 % 128))
          JOBQ(w3a, WT1A, CMAXA, (n0 / 128) * 256 + 128 + (n0 % 128))
          JOBQ(w1b, WT1B, CMAXB, (n0 / 128) * 256 + (n0 % 128))
          JOBQ(w3b, WT1B, CMAXB, (n0 / 128) * 256 + 128 + (n0 % 128))
#undef JOBQ
#define JOBQW(col0, nvalid_, ntotal_, drow0_) { const int nb_ = (ntotal_) / 32, n_ = (D / 64) * nb_; \
            for (; it < base + n_; it += NGW) { const int loc = it - base, kb = loc / nb_, n0 = (loc % nb_) * 32; const int nv = ((nvalid_) - n0) < 32 ? ((nvalid_) - n0) : 32; \
                tr_item_q8(w_in, INW, (col0) + n0, kb * 64, (unsigned char*)WIN, D, (drow0_) + n0, CMAXW, scr, lane, nv); } base += n_; }
          JOBQW(0, 448, 448, 0) JOBQW(448, 4, 64, 448) JOBQW(452, 3584, 3584, 512)
#undef JOBQW
#define JOBQ2(Wp, WTp, CMp) { const int nb_ = D / 32, n_ = (FF / 64) * nb_; \
            for (; it < base + n_; it += NGW) { const int loc = it - base, kb = loc / nb_, n0 = (loc % nb_) * 32; tr_item_q8(Wp, D, n0, kb * 64, (unsigned char*)(WTp), FF, n0, CMp, scr, lane); } base += n_; }
          JOBQ2(w2a, W2TA, CMAXDA) JOBQ2(w2b, W2TB, CMAXDB)
#undef JOBQ2
        }
        normmod_phase<true>(x, g_ffn1, MODS + 0 * D, MODS + 1 * D, XN, RS, gw, NGW, lane); }
    SEAM(1);
    if (IN(2)) { DECL_PTRS pg8::Gemm g{XN, WT1A, M, 2 * FF, D / 2}; pg8::StaticOrder S; S.init(M, 2 * FF, G, bx); pg8::EpiSwigluI8 E{U, FF, RS, (const float*)CMAXA};
        pg8::gemm_phase<pg8::EpiSwigluI8, pg8::StaticOrder, true, true, true>(lds, g, S, E, wave); }
    SEAM(2);
    if (IN(3)) { DECL_PTRS uquant_phase(U, U8, RSU, gw, NGW, lane); xcd_barrier(bar);
        pg8::Gemm g{(const bf16*)U8, W2TA, M, D, FF / 2}; pg8::StaticOrder S; S.init(M, D, G, bx); pg8::EpiResidB<false, true, true> E{x, X1, D, MODS + 2 * D, MODW, RSU, (const float*)CMAXDA};
        pg8::gemm_phase<pg8::EpiResidB<false, true, true>, pg8::StaticOrder, true, true, true>(lds, g, S, E, wave); }
    SEAM(3);
    if (IN(4)) { DECL_PTRS normmod_bf_phase<true>(X1, g_mix, MODS + 3 * D, MODS + 4 * D, XN, RS, gw, NGW, lane); }
    SEAM(4);
    if (IN(5)) { DECL_PTRS pg8::Gemm g{XN, WIN, M, PW, D / 2}; pg8::StaticOrder S; S.init(M, PW, G, bx); pg8::EpiStoreI8 E{PB, PW, RS, (const float*)CMAXW, 2, 4, 0.125f * LOG2E};
        pg8::gemm_phase<pg8::EpiStoreI8, pg8::StaticOrder, true, true, true>(lds, g, S, E, wave); }
    SEAM(5);
    if (IN(6)) { DECL_PTRS smallnorm_phase(PB, g_cq, g_ckv, g_kidx, b_kidx, CQN, CKVN, KIDXN, WIDX, gw, NGW, lane); kmean_phase(lds, PB, (float*)(ws + WS_KMG), bx, G, tid); }
    SEAM(6);
    if (IN(7)) { DECL_PTRS pg8::Gemm g{CQN, WQ, M, 1280, 256}; pg8::StaticOrder S; S.init(M, 1280, G, bx); pg8::EpiStore2 E{QLAT, 1024, 4, QIDX, 256};
        pg8::gemm_phase<pg8::EpiStore2, pg8::StaticOrder, true, true>(lds, g, S, E, wave); }
    SEAM(7);
    if (IN(8)) { DECL_PTRS
        unsigned* MASKG = (unsigned*)(ws + WS_MASK);
        if (!(pflags & 1)) {
            for (int idx = bx; idx < BATCH * 64; idx += G) {
                const int i = idx / G, c = idx % G;
                int b, qt;
                if (G == 256) { b = c & 31; const int hi3 = c >> 5; qt = (i & 1) ? (8 * i + 7 - hi3) : (8 * i + hi3); }
                else { b = idx & 31; qt = idx >> 5; }
                if (!(pflags & 16)) dsa_select(lds, b, qt, QIDX, KIDXN, WIDX, MASKG, tid, lane, wave, pflags);
            }
            asm volatile("s_waitcnt vmcnt(0)" ::: "memory"); __syncthreads();
            if (!(pflags & 4))
            for (int idx = bx; idx < BATCH * 64; idx += G) {
                const int i = idx / G, c = idx % G;
                int b, qt;
                if (G == 256) { b = c & 31; const int hi3 = c >> 5; qt = (i & 1) ? (8 * i + 7 - hi3) : (8 * i + hi3); }
                else { b = idx & 31; qt = idx >> 5; }
                dsa_attn(lds, b, qt, MASKG, QLAT, CKVN, WUVT, ODSA, tid, lane, wave, PROBE_VARIANTS ? pflags : 0);
            }
        }
        if (!(pflags & 2))
        for (int bh = bx; bh < BATCH * 8; bh += G) moba_bh(lds, bh >> 3, bh & 7, PB, (const float*)(ws + WS_KMG), OMOBA, tid, lane, wave, PROBE_VARIANTS ? pflags : 0);
    }
    SEAM(8);
    if (IN(9)) { DECL_PTRS pg8::Gemm g{ODSA, WPD, M, D, 512}; pg8::StaticOrder S; S.init(M, D, G, bx); pg8::EpiGate<false> E{T1, nullptr, D, PB + PC_GA, PW};
        pg8::gemm_phase<pg8::EpiGate<false>, pg8::StaticOrder, true, true>(lds, g, S, E, wave); }
    if (IN(9) && IN(10)) { asm volatile("s_waitcnt vmcnt(0)" ::: "memory"); __syncthreads(); __builtin_amdgcn_fence(__ATOMIC_ACQUIRE, "agent"); asm volatile("s_waitcnt vmcnt(0)" ::: "memory"); }
    if (IN(10)) { DECL_PTRS pg8::Gemm g{OMOBA, WPM, M, D, 512}; pg8::StaticOrder S; S.init(M, D, G, bx); pg8::EpiGate<true> E{Y, T1, D, PB + PC_GB, PW};
        pg8::gemm_phase<pg8::EpiGate<true>, pg8::StaticOrder, true, true>(lds, g, S, E, wave); }
    SEAM(10);
    if (IN(11)) { DECL_PTRS pg8::Gemm g{Y, WOUT, M, D, D}; pg8::StaticOrder S; S.init(M, D, G, bx); pg8::EpiResidB<true, false, false> E{X1, X2, D, MODS + 5 * D, MODW, MODS, MODS};
        pg8::gemm_phase<pg8::EpiResidB<true, false, false>, pg8::StaticOrder, true, true>(lds, g, S, E, wave); }
    SEAM(11);
    if (IN(12)) { DECL_PTRS normmod_bf_phase<true>(X2, g_ffn2, MODS + 6 * D, MODS + 7 * D, XN, RS, gw, NGW, lane); }
    SEAM(12);
    if (IN(13)) { DECL_PTRS pg8::Gemm g{XN, WT1B, M, 2 * FF, D / 2}; pg8::StaticOrder S; S.init(M, 2 * FF, G, bx); pg8::EpiSwigluI8 E{U, FF, RS, (const float*)CMAXB};
        pg8::gemm_phase<pg8::EpiSwigluI8, pg8::StaticOrder, true, true, true>(lds, g, S, E, wave); }
    SEAM(13);
    if (IN(14)) { DECL_PTRS uquant_phase(U, U8, RSU, gw, NGW, lane); xcd_barrier(bar);
        pg8::Gemm g{(const bf16*)U8, W2TB, M, D, FF / 2}; pg8::StaticOrder S; S.init(M, D, G, bx); pg8::EpiResidB<true, true, true> E{X2, X3, D, MODS + 8 * D, MODW, RSU, (const float*)CMAXDB};
        pg8::gemm_phase<pg8::EpiResidB<true, true, true>, pg8::StaticOrder, true, true, true>(lds, g, S, E, wave); }
    SEAM(14);
    if (IN(15)) { DECL_PTRS finalnorm_phase(X3, g_final, out, gw, NGW, lane); }
#undef IN
#undef SEAM
}

extern "C" void kernel_launch(void* const* d_in, const int* in_sizes, int n_in, void* d_out, int out_size, void* d_ws, size_t ws_size, hipStream_t stream) {
    static int grid = 0;
    if (grid == 0) {
        if (n_in != 26 || in_sizes[0] != M * D || out_size != M * D || ws_size < WS_END) { fprintf(stderr, "kernel_launch: unexpected shapes (n_in %d, in0 %d, out %d, ws %zu)\n", n_in, n_in > 0 ? in_sizes[0] : -1, out_size, ws_size); grid = -1; return; }
        int dev = 0, cus = 0, per_cu = 0;
        if (hipGetDevice(&dev) != hipSuccess || hipDeviceGetAttribute(&cus, hipDeviceAttributeMultiprocessorCount, dev) != hipSuccess) { grid = -1; return; }
        if (hipFuncSetAttribute((const void*)mk_fwd, hipFuncAttributeMaxDynamicSharedMemorySize, LDS_BYTES) != hipSuccess) { fprintf(stderr, "kernel_launch: hipFuncSetAttribute failed\n"); grid = -1; return; }
        if (hipOccupancyMaxActiveBlocksPerMultiprocessor(&per_cu, (const void*)mk_fwd, NWAVES * 64, LDS_BYTES) != hipSuccess || per_cu < 1) fprintf(stderr, "kernel_launch: occupancy query reports %d\n", per_cu);
        (void)hipGetLastError();
        grid = cus;
    }
    if (grid < 0) return;
    if (hipMemsetAsync((char*)d_ws + WS_CTL, 0, CTL_ZERO_BYTES, stream) != hipSuccess) return;
    Args a{};
    for (int i = 0; i < 26; ++i) a.in[i] = (const float*)d_in[i];
    a.out = (float*)d_out; a.ws = (unsigned char*)d_ws;
    if (MK_ONE_LAUNCH) { a.ph_lo = 0; a.ph_hi = NPHASE; hipLaunchKernelGGL(mk_fwd, dim3(grid), dim3(NWAVES * 64), LDS_BYTES, stream, a); }
    else for (int p = 0; p < NPHASE; ++p) { a.ph_lo = p; a.ph_hi = p + 1;
#if defined(PROBE_PHASE) && defined(PROBE_BEFORE)
        if (p == PROBE_PHASE) for (int e = 0; e < PROBE_REPS; ++e) { a.flags = PROBE_FLAGS; hipLaunchKernelGGL(mk_fwd, dim3(grid), dim3(NWAVES * 64), LDS_BYTES, stream, a); }
#endif
        a.flags = 0; hipLaunchKernelGGL(mk_fwd, dim3(grid), dim3(NWAVES * 64), LDS_BYTES, stream, a);
#if defined(PROBE_PHASE) && !defined(PROBE_BEFORE)
        if (p == PROBE_PHASE) for (int e = 0; e < PROBE_REPS; ++e) { a.flags = PROBE_FLAGS; hipLaunchKernelGGL(mk_fwd, dim3(grid), dim3(NWAVES * 64), LDS_BYTES, stream, a); }
#endif
    }
}
```

```cpp
#include <hip/hip_runtime.h>
#include <cstdio>
#include <cstdint>
__device__ __forceinline__ int lane_id() { return (int)__builtin_amdgcn_mbcnt_hi(~0u, __builtin_amdgcn_mbcnt_lo(~0u, 0u)); }
__device__ __forceinline__ unsigned pk4_i8(float a, float b, float c, float d);
namespace pg8 {
#define PG8_LAS __attribute__((address_space(3)))
typedef unsigned short bf16_t;
typedef short bf16x8 __attribute__((ext_vector_type(8)));
typedef float f32x4 __attribute__((ext_vector_type(4)));
typedef unsigned u32x4 __attribute__((ext_vector_type(4)));
constexpr int BM = 256, BK = 64, HALF = 128, HTB = HALF * BK * 2  , STAGE_BYTES = 8 * HTB, NXCD = 8, WGM = 8;

__host__ __device__ __forceinline__ int lds_byte(int r, int c) { const int st = (r >> 4) * 2 + (c >> 5), rr = r & 15, cc = c & 31, ob = rr * 64 + cc * 2; return st * 1024 + (ob ^ (((ob >> 9) & 1) << 5)); }
__host__ __device__ __forceinline__ void stage_rc(int b, int& R, int& C) { const int st = b / 1024, sb = b % 1024, swz = sb ^ (((sb >> 9) & 1) << 5); R = (st >> 1) * 16 + swz / 64; C = (st & 1) * 32 + (swz % 64) / 2; }
__host__ __device__ __forceinline__ int perm32(int rho) { const int n = rho >> 4, i = rho & 15; return 8 * (i >> 2) + 4 * n + (i & 3); }

struct Unit { int pm, pn; };
struct Gemm { const bf16_t* A; const bf16_t* Bt; int M, N, K, lda; const bf16_t* A2; const bf16_t* Bt2; };

struct StaticOrder {
    int nM, nN, nwg, G, c;
    __host__ __device__ void init(int M, int N, int G_, int c_) { nM = M / BM; nN = N / BM; nwg = nM * nN; G = G_; c = c_; }
    __host__ __device__ bool next(int i, Unit& u) const {
        const long L = (long)i * G + c; if (L >= nwg) return false;
        int wgid = (int)L; { const int q = nwg / NXCD, r = nwg % NXCD, xcd = wgid % NXCD, off = wgid / NXCD; wgid = (xcd < r ? xcd * (q + 1) : r * (q + 1) + (xcd - r) * q) + off; }
        const int nig = WGM * nN, gid = wgid / nig, fm = gid * WGM, gsz = (nM - fm) < WGM ? (nM - fm) : WGM;
        u.pm = fm + ((wgid % nig) % gsz); u.pn = (wgid % nig) / gsz; return true;
    }
    __device__ __forceinline__ void a_ready(const Unit&) const {}
    __device__ __forceinline__ void done(const Unit&) const {}
};

__device__ __forceinline__ unsigned cvt_pk_bf16(float lo, float hi) { unsigned r; asm volatile("v_cvt_pk_bf16_f32 %0, %1, %2" : "=v"(r) : "v"(lo), "v"(hi)); return r; }
typedef unsigned u32x2 __attribute__((ext_vector_type(2)));
typedef float f32x2 __attribute__((ext_vector_type(2)));
__device__ __forceinline__ float bflo(unsigned w) { return __uint_as_float(w << 16); }
__device__ __forceinline__ float bfhi(unsigned w) { return __uint_as_float(w & 0xffff0000u); }
__device__ __forceinline__ float fast_sigmoid(float x) { return __builtin_amdgcn_rcpf(1.0f + __builtin_amdgcn_exp2f(-1.4426950408889634f * x)); }

struct EpiSwiglu {
    static constexpr bool PERM = true, AFTER_DRAIN = false;
    bf16_t* O; int ldc;
    __device__ __forceinline__ void operator()(const f32x4 (&acc)[2][2][4][2], const Unit& u, int wr, int wc, int fr_, int fq_) const {
        int fr = fr_, fq = fq_; asm volatile("" : "+v"(fr), "+v"(fq));
        const int row0 = u.pm * BM + wr * 64 + fr, col0 = u.pn * HALF + wc * 32 + 8 * fq;
#pragma unroll
        for (int ai = 0; ai < 2; ++ai)
#pragma unroll
            for (int m = 0; m < 4; ++m) {
                bf16_t* rowp = O + (size_t)(row0 + ai * HALF + m * 16) * ldc + col0;
                float o[8];
#pragma unroll
                for (int n = 0; n < 2; ++n)
#pragma unroll
                    for (int j = 0; j < 4; j += 2) { const f32x2 a = (f32x2){acc[ai][0][m][n][j], acc[ai][0][m][n][j + 1]}, g = (f32x2){acc[ai][1][m][n][j], acc[ai][1][m][n][j + 1]};
                        const f32x2 t = a * (-1.4426950408889634f); f32x2 e; e.x = __builtin_amdgcn_exp2f(t.x); e.y = __builtin_amdgcn_exp2f(t.y);
                        const f32x2 d = e + 1.0f; f32x2 rc; rc.x = __builtin_amdgcn_rcpf(d.x); rc.y = __builtin_amdgcn_rcpf(d.y);
                        const f32x2 r2 = (a * g) * rc; o[4 * n + j] = r2.x; o[4 * n + j + 1] = r2.y; }
                u32x4 w; w.x = cvt_pk_bf16(o[0], o[1]); w.y = cvt_pk_bf16(o[2], o[3]); w.z = cvt_pk_bf16(o[4], o[5]); w.w = cvt_pk_bf16(o[6], o[7]);
                *(u32x4*)rowp = w;
            }
    }
};
struct EpiSwigluI8 {
    static constexpr bool PERM = true, AFTER_DRAIN = false;
    bf16_t* O; int ldc; const float* sa; const float* sb;
    __device__ __forceinline__ void operator()(const f32x4 (&acc)[2][2][4][2], const Unit& u, int wr, int wc, int fr_, int fq_) const {
        int fr = fr_, fq = fq_; asm volatile("" : "+v"(fr), "+v"(fq));
        typedef int v4i_ __attribute__((ext_vector_type(4)));
        const int row0 = u.pm * BM + wr * 64 + fr, col0 = u.pn * HALF + wc * 32 + 8 * fq;
        const float* bp = sb + u.pn * BM + wc * 32 + 8 * fq;
        f32x4 s1[2], s3[2];
#pragma unroll
        for (int n = 0; n < 2; ++n) { s1[n] = *(const f32x4*)(bp + 4 * n); s3[n] = *(const f32x4*)(bp + HALF + 4 * n); }
#pragma unroll
        for (int ai = 0; ai < 2; ++ai)
#pragma unroll
            for (int m = 0; m < 4; ++m) {
                const int row = row0 + ai * HALF + m * 16; const float ra = sa[row] * (1.0f / 127.0f);
                bf16_t* rowp = O + (size_t)row * ldc + col0;
                float o[8];
#pragma unroll
                for (int n = 0; n < 2; ++n) { const v4i_ ia = __builtin_bit_cast(v4i_, acc[ai][0][m][n]), ig = __builtin_bit_cast(v4i_, acc[ai][1][m][n]);
#pragma unroll
                    for (int j = 0; j < 4; j += 2) { const f32x2 a = (f32x2){(float)ia[j], (float)ia[j + 1]} * ((f32x2){s1[n][j], s1[n][j + 1]} * ra), g = (f32x2){(float)ig[j], (float)ig[j + 1]} * ((f32x2){s3[n][j], s3[n][j + 1]} * ra);
                        const f32x2 t = a * (-1.4426950408889634f); f32x2 e; e.x = __builtin_amdgcn_exp2f(t.x); e.y = __builtin_amdgcn_exp2f(t.y);
                        const f32x2 d = e + 1.0f; f32x2 rc; rc.x = __builtin_amdgcn_rcpf(d.x); rc.y = __builtin_amdgcn_rcpf(d.y);
                        const f32x2 r2 = (a * g) * rc; o[4 * n + j] = r2.x; o[4 * n + j + 1] = r2.y; } }
                u32x4 w; w.x = cvt_pk_bf16(o[0], o[1]); w.y = cvt_pk_bf16(o[2], o[3]); w.z = cvt_pk_bf16(o[4], o[5]); w.w = cvt_pk_bf16(o[6], o[7]);
                *(u32x4*)rowp = w;
            }
    }
};
#define KAPPA 8.0f
struct EpiSwigluQ {
    static constexpr bool PERM = true, AFTER_DRAIN = false;
    unsigned char* O; int ldc; const float* sa; const float* sb; const unsigned long long* csq; const float* r2;
    __device__ __forceinline__ void operator()(const f32x4 (&acc)[2][2][4][2], const Unit& u, int wr, int wc, int fr_, int fq_) const {
        int fr = fr_, fq = fq_; asm volatile("" : "+v"(fr), "+v"(fq));
        typedef int v4i_ __attribute__((ext_vector_type(4)));
        const int row0 = u.pm * BM + wr * 64 + fr, col0 = u.pn * HALF + wc * 32 + 8 * fq;
        const int bo = u.pn * BM + wc * 32 + 8 * fq;
        f32x4 s1[2], s3[2], kq[2];
#pragma unroll
        for (int n = 0; n < 2; ++n) { s1[n] = *(const f32x4*)(sb + bo + 4 * n); s3[n] = *(const f32x4*)(sb + bo + HALF + 4 * n);
            const unsigned long long* c1 = csq + bo + 4 * n; const unsigned long long* c3 = c1 + HALF;
#pragma unroll
            for (int j = 0; j < 4; ++j) kq[n][j] = __builtin_amdgcn_rsqf(fmaxf(((float)c1[j] * 2.3283064365386963e-10f) * ((float)c3[j] * 2.3283064365386963e-10f), 1e-30f)) * (127.0f / KAPPA); }
        float ras[8], rqs[8];
#pragma unroll
        for (int q8 = 0; q8 < 8; ++q8) { const int row = row0 + (q8 >> 2) * HALF + (q8 & 3) * 16; ras[q8] = sa[row]; rqs[q8] = r2[row]; }
#pragma unroll
        for (int ai = 0; ai < 2; ++ai)
#pragma unroll
            for (int m = 0; m < 4; ++m) {
                const int row = row0 + ai * HALF + m * 16; const float ra = ras[ai * 4 + m] * (1.0f / 127.0f); const float rq = __builtin_amdgcn_rcpf(fmaxf(rqs[ai * 4 + m], 1e-30f));
                float o[8];
#pragma unroll
                for (int n = 0; n < 2; ++n) { const v4i_ ia = __builtin_bit_cast(v4i_, acc[ai][0][m][n]), ig = __builtin_bit_cast(v4i_, acc[ai][1][m][n]);
#pragma unroll
                    for (int j = 0; j < 4; j += 2) { const f32x2 a = (f32x2){(float)ia[j], (float)ia[j + 1]} * ((f32x2){s1[n][j], s1[n][j + 1]} * ra), g = (f32x2){(float)ig[j], (float)ig[j + 1]} * ((f32x2){s3[n][j], s3[n][j + 1]} * ra);
                        const f32x2 t = a * (-1.4426950408889634f); f32x2 e; e.x = __builtin_amdgcn_exp2f(t.x); e.y = __builtin_amdgcn_exp2f(t.y);
                        const f32x2 d = e + 1.0f; f32x2 rc; rc.x = __builtin_amdgcn_rcpf(d.x); rc.y = __builtin_amdgcn_rcpf(d.y);
                        const f32x2 r2v = __builtin_elementwise_fma((a * g) * rc, (f32x2){kq[n][j], kq[n][j + 1]} * rq, (f32x2){12582912.0f, 12582912.0f});
                        o[4 * n + j] = __builtin_amdgcn_fmed3f(r2v.x, 12582912.0f - 127.0f, 12582912.0f + 127.0f); o[4 * n + j + 1] = __builtin_amdgcn_fmed3f(r2v.y, 12582912.0f - 127.0f, 12582912.0f + 127.0f); } }
                u32x2 w;
                { const unsigned p01 = __builtin_amdgcn_perm(__float_as_uint(o[1]), __float_as_uint(o[0]), 0x0c0c0400u), p23 = __builtin_amdgcn_perm(__float_as_uint(o[3]), __float_as_uint(o[2]), 0x0c0c0400u);
                  const unsigned p45 = __builtin_amdgcn_perm(__float_as_uint(o[5]), __float_as_uint(o[4]), 0x0c0c0400u), p67 = __builtin_amdgcn_perm(__float_as_uint(o[7]), __float_as_uint(o[6]), 0x0c0c0400u);
                  w.x = __builtin_amdgcn_perm(p23, p01, 0x05040100u); w.y = __builtin_amdgcn_perm(p67, p45, 0x05040100u); }
                *(u32x2*)(O + (size_t)row * ldc + col0) = w;
            }
    }
};
struct EpiStoreI8 {
    static constexpr bool PERM = true, AFTER_DRAIN = false;
    bf16_t* O; int ldc; const float* sa; const float* sb; int pn_lo, pn_hi; float qscale;
    __device__ __forceinline__ void operator()(const f32x4 (&acc)[2][2][4][2], const Unit& u, int wr, int wc, int fr_, int fq_) const {
        int fr = fr_, fq = fq_; asm volatile("" : "+v"(fr), "+v"(fq));
        typedef int v4i_ __attribute__((ext_vector_type(4)));
        const int row0 = u.pm * BM + wr * 64 + fr, col0 = u.pn * BM + wc * 32 + 8 * fq;
        const float cs = (u.pn >= pn_lo && u.pn < pn_hi) ? qscale * (1.0f / 127.0f) : (1.0f / 127.0f);
        f32x4 bb[2][2];
#pragma unroll
        for (int bj = 0; bj < 2; ++bj)
#pragma unroll
            for (int n = 0; n < 2; ++n) bb[bj][n] = *(const f32x4*)(sb + col0 + bj * HALF + 4 * n) * cs;
        float ras[8];
#pragma unroll
        for (int q8 = 0; q8 < 8; ++q8) ras[q8] = sa[row0 + (q8 >> 2) * HALF + (q8 & 3) * 16];
#pragma unroll
        for (int ai = 0; ai < 2; ++ai)
#pragma unroll
            for (int m = 0; m < 4; ++m) {
                const int row = row0 + ai * HALF + m * 16; const float ra = ras[ai * 4 + m];
                bf16_t* rowp = O + (size_t)row * ldc + col0;
#pragma unroll
                for (int bj = 0; bj < 2; ++bj) {
                    const v4i_ i0 = __builtin_bit_cast(v4i_, acc[ai][bj][m][0]), i1 = __builtin_bit_cast(v4i_, acc[ai][bj][m][1]);
                    const f32x4 v0 = (f32x4){(float)i0[0], (float)i0[1], (float)i0[2], (float)i0[3]} * (bb[bj][0] * ra), v1 = (f32x4){(float)i1[0], (float)i1[1], (float)i1[2], (float)i1[3]} * (bb[bj][1] * ra);
                    u32x4 w; w.x = cvt_pk_bf16(v0[0], v0[1]); w.y = cvt_pk_bf16(v0[2], v0[3]); w.z = cvt_pk_bf16(v1[0], v1[1]); w.w = cvt_pk_bf16(v1[2], v1[3]);
                    *(u32x4*)(rowp + bj * HALF) = w;
                }
            }
    }
};
struct EpiResid {
    static constexpr bool PERM = false, AFTER_DRAIN = false;
    const float* base; float* out; int ldc; const float* gate; int gstride; float coef;
    __device__ __forceinline__ void operator()(const f32x4 (&acc)[2][2][4][2], const Unit& u, int wr, int wc, int fr_, int fq_) const {
        int fr = fr_, fq = fq_; asm volatile("" : "+v"(fr), "+v"(fq));
        const float* gp = gate + (size_t)(u.pm >> 3) * gstride;
        const int col0 = u.pn * BM + wc * 32 + 4 * fq;
#pragma unroll
        for (int bj = 0; bj < 2; ++bj)
#pragma unroll
            for (int n = 0; n < 2; ++n) {
                const f32x4 gv = *(const f32x4*)(gp + col0 + bj * HALF + n * 16);
                const f32x4 s = (gv + 1.0f) * coef;
#pragma unroll
                for (int ai = 0; ai < 2; ++ai)
#pragma unroll
                    for (int m = 0; m < 4; ++m) {
                        const size_t off = (size_t)(u.pm * BM + ai * HALF + wr * 64 + m * 16 + fr) * ldc + col0 + bj * HALF + n * 16;
                        const f32x4 bs = *(const f32x4*)(base + off);
                        *(f32x4*)(out + off) = bs + s * acc[ai][bj][m][n];
                    }
            }
    }
};
template <bool BASE_BF16, bool I8, bool HALF_COEF> struct EpiResidB {
    static constexpr bool PERM = true, AFTER_DRAIN = false;
    const void* base; bf16_t* out; int ldc; const float* gate; int gstride; const float* sa; const float* sb; const float* cm;
    __device__ __forceinline__ void operator()(const f32x4 (&acc)[2][2][4][2], const Unit& u, int wr, int wc, int fr_, int fq_) const {
        int fr = fr_, fq = fq_; asm volatile("" : "+v"(fr), "+v"(fq));
        const float* gp = gate + (size_t)(u.pm >> 3) * gstride;
        const int row0 = u.pm * BM + wr * 64 + fr, col0 = u.pn * BM + wc * 32 + 8 * fq;
        f32x4 sv[2][2]; float cmk = 1.0f; if (I8) cmk = *cm * (KAPPA / 127.0f);
#pragma unroll
        for (int bj = 0; bj < 2; ++bj)
#pragma unroll
            for (int n = 0; n < 2; ++n) { sv[bj][n] = (*(const f32x4*)(gp + col0 + bj * HALF + 4 * n) + 1.0f) * (HALF_COEF ? 0.5f : 1.0f); if (I8) sv[bj][n] = sv[bj][n] * (*(const f32x4*)(sb + col0 + bj * HALF + 4 * n) * (1.0f / 127.0f)); }
        float ras[8];
#pragma unroll
        for (int q8 = 0; q8 < 8; ++q8) { ras[q8] = 1.0f; if (I8) ras[q8] = sa[row0 + (q8 >> 2) * HALF + (q8 & 3) * 16] * cmk; }
        u32x4 nb[2][2];
#define RB_LOAD(q8_) { const size_t ro_ = (size_t)(row0 + ((q8_) >> 2) * HALF + ((q8_) & 3) * 16) * ldc + col0; \
            _Pragma("unroll") for (int bj = 0; bj < 2; ++bj) { \
                if (BASE_BF16) nb[bj][0] = *(const u32x4*)((const bf16_t*)base + ro_ + bj * HALF); \
                else { nb[bj][0] = *(const u32x4*)((const float*)base + ro_ + bj * HALF); nb[bj][1] = *(const u32x4*)((const float*)base + ro_ + bj * HALF + 4); } } }
        RB_LOAD(0)
#pragma unroll
        for (int ai = 0; ai < 2; ++ai)
#pragma unroll
            for (int m = 0; m < 4; ++m) {
                const size_t roff = (size_t)(row0 + ai * HALF + m * 16) * ldc + col0; const float ra = ras[ai * 4 + m];
                u32x4 cb[2][2];
#pragma unroll
                for (int bj = 0; bj < 2; ++bj) { cb[bj][0] = nb[bj][0]; cb[bj][1] = nb[bj][1]; }
                if (ai * 4 + m + 1 < 8) RB_LOAD(ai * 4 + m + 1)
#pragma unroll
                for (int bj = 0; bj < 2; ++bj) {
                    f32x4 b0, b1;
                    if (BASE_BF16) { const u32x4 bw = cb[bj][0]; b0 = (f32x4){bflo(bw.x), bfhi(bw.x), bflo(bw.y), bfhi(bw.y)}; b1 = (f32x4){bflo(bw.z), bfhi(bw.z), bflo(bw.w), bfhi(bw.w)}; }
                    else { b0 = __builtin_bit_cast(f32x4, cb[bj][0]); b1 = __builtin_bit_cast(f32x4, cb[bj][1]); }
                    f32x4 a0 = acc[ai][bj][m][0], a1 = acc[ai][bj][m][1];
                    if (I8) { typedef int v4i_ __attribute__((ext_vector_type(4))); const v4i_ i0 = __builtin_bit_cast(v4i_, a0), i1 = __builtin_bit_cast(v4i_, a1);
                        a0 = (f32x4){(float)i0[0], (float)i0[1], (float)i0[2], (float)i0[3]} * ra; a1 = (f32x4){(float)i1[0], (float)i1[1], (float)i1[2], (float)i1[3]} * ra; }
                    const f32x4 o0 = b0 + sv[bj][0] * a0, o1 = b1 + sv[bj][1] * a1;
                    u32x4 w; w.x = cvt_pk_bf16(o0[0], o0[1]); w.y = cvt_pk_bf16(o0[2], o0[3]); w.z = cvt_pk_bf16(o1[0], o1[1]); w.w = cvt_pk_bf16(o1[2], o1[3]);
                    *(u32x4*)(out + roff + bj * HALF) = w;
                }
            }
    }
};
#undef RB_LOAD
struct EpiStore2 {
    static constexpr bool PERM = true, AFTER_DRAIN = false;
    bf16_t* O0; int ld0; int split_pn; bf16_t* O1; int ld1;
    __device__ __forceinline__ void operator()(const f32x4 (&acc)[2][2][4][2], const Unit& u, int wr, int wc, int fr_, int fq_) const {
        int fr = fr_, fq = fq_; asm volatile("" : "+v"(fr), "+v"(fq));
        const bool first = u.pn < split_pn;
        bf16_t* base = first ? O0 : O1; const int ld = first ? ld0 : ld1; const int colt = (first ? u.pn : u.pn - split_pn) * BM;
        const int row0 = u.pm * BM + wr * 64 + fr, col0 = colt + wc * 32 + 8 * fq;
#pragma unroll
        for (int ai = 0; ai < 2; ++ai)
#pragma unroll
            for (int m = 0; m < 4; ++m) {
                bf16_t* rowp = base + (size_t)(row0 + ai * HALF + m * 16) * ld + col0;
#pragma unroll
                for (int bj = 0; bj < 2; ++bj) {
                    const f32x4 v0 = acc[ai][bj][m][0], v1 = acc[ai][bj][m][1];
                    u32x4 w; w.x = cvt_pk_bf16(v0[0], v0[1]); w.y = cvt_pk_bf16(v0[2], v0[3]); w.z = cvt_pk_bf16(v1[0], v1[1]); w.w = cvt_pk_bf16(v1[2], v1[3]);
                    *(u32x4*)(rowp + bj * HALF) = w;
                }
            }
    }
};
template <bool HAS_ADD> struct EpiGate {
    static constexpr bool PERM = true, AFTER_DRAIN = false;
    bf16_t* O; const bf16_t* add; int ldc; const bf16_t* G; int ldg;
    __device__ __forceinline__ void operator()(const f32x4 (&acc)[2][2][4][2], const Unit& u, int wr, int wc, int fr_, int fq_) const {
        int fr = fr_, fq = fq_; asm volatile("" : "+v"(fr), "+v"(fq));
        const int row0 = u.pm * BM + wr * 64 + fr, col0 = u.pn * BM + wc * 32 + 8 * fq;
#pragma unroll
        for (int ai = 0; ai < 2; ++ai)
#pragma unroll
            for (int m = 0; m < 4; ++m) {
                const size_t row = (size_t)(row0 + ai * HALF + m * 16);
#pragma unroll
                for (int bj = 0; bj < 2; ++bj) {
                    const u32x4 gw = *(const u32x4*)(G + row * ldg + col0 + bj * HALF);
                    u32x4 aw = (u32x4){0u, 0u, 0u, 0u};
                    if (HAS_ADD) aw = *(const u32x4*)(add + row * ldc + col0 + bj * HALF);
                    const f32x4 v0 = acc[ai][bj][m][0], v1 = acc[ai][bj][m][1];
                    float o[8];
                    o[0] = bflo(aw.x) + fast_sigmoid(bflo(gw.x)) * v0[0]; o[1] = bfhi(aw.x) + fast_sigmoid(bfhi(gw.x)) * v0[1];
                    o[2] = bflo(aw.y) + fast_sigmoid(bflo(gw.y)) * v0[2]; o[3] = bfhi(aw.y) + fast_sigmoid(bfhi(gw.y)) * v0[3];
                    o[4] = bflo(aw.z) + fast_sigmoid(bflo(gw.z)) * v1[0]; o[5] = bfhi(aw.z) + fast_sigmoid(bfhi(gw.z)) * v1[1];
                    o[6] = bflo(aw.w) + fast_sigmoid(bflo(gw.w)) * v1[2]; o[7] = bfhi(aw.w) + fast_sigmoid(bfhi(gw.w)) * v1[3];
                    u32x4 w; w.x = cvt_pk_bf16(o[0], o[1]); w.y = cvt_pk_bf16(o[2], o[3]); w.z = cvt_pk_bf16(o[4], o[5]); w.w = cvt_pk_bf16(o[6], o[7]);
                    *(u32x4*)(O + row * ldc + col0 + bj * HALF) = w;
                }
            }
    }
};

struct EpiGate2 {
    static constexpr bool PERM = true, AFTER_DRAIN = false;
    bf16_t* O; int ldc; const bf16_t* GA; const bf16_t* GB; int ldg;
    __device__ __forceinline__ static float e_neg(float g) { return __builtin_amdgcn_exp2f(fminf(-1.4426950408889634f * g, 115.0f)); }
    __device__ __forceinline__ void mid(f32x4 (&acc)[2][2][4][2], const Unit& u, int wr, int wc, int fr_, int fq_) const {
        int fr = fr_, fq = fq_; asm volatile("" : "+v"(fr), "+v"(fq));
        const int row0 = u.pm * BM + wr * 64 + fr, col0 = u.pn * BM + wc * 32 + 8 * fq;
#pragma unroll
        for (int ai = 0; ai < 2; ++ai)
#pragma unroll
            for (int m = 0; m < 4; ++m) {
                const size_t row = (size_t)(row0 + ai * HALF + m * 16);
#pragma unroll
                for (int bj = 0; bj < 2; ++bj) {
                    const u32x4 ga = *(const u32x4*)(GA + row * ldg + col0 + bj * HALF), gb = *(const u32x4*)(GB + row * ldg + col0 + bj * HALF);
                    const float a_[8] = {bflo(ga.x), bfhi(ga.x), bflo(ga.y), bfhi(ga.y), bflo(ga.z), bfhi(ga.z), bflo(ga.w), bfhi(ga.w)};
                    const float b_[8] = {bflo(gb.x), bfhi(gb.x), bflo(gb.y), bfhi(gb.y), bflo(gb.z), bfhi(gb.z), bflo(gb.w), bfhi(gb.w)};
#pragma unroll
                    for (int j = 0; j < 8; ++j) { const float rt = (1.0f + e_neg(b_[j])) * __builtin_amdgcn_rcpf(1.0f + e_neg(a_[j])); acc[ai][bj][m][j >> 2][j & 3] *= rt; }
                }
            }
    }
    __device__ __forceinline__ void operator()(const f32x4 (&acc)[2][2][4][2], const Unit& u, int wr, int wc, int fr_, int fq_) const {
        int fr = fr_, fq = fq_; asm volatile("" : "+v"(fr), "+v"(fq));
        const int row0 = u.pm * BM + wr * 64 + fr, col0 = u.pn * BM + wc * 32 + 8 * fq;
        u32x4 ng[2];
#pragma unroll
        for (int bj = 0; bj < 2; ++bj) ng[bj] = *(const u32x4*)(GB + (size_t)row0 * ldg + col0 + bj * HALF);
#pragma unroll
        for (int ai = 0; ai < 2; ++ai)
#pragma unroll
            for (int m = 0; m < 4; ++m) {
                const size_t row = (size_t)(row0 + ai * HALF + m * 16);
                u32x4 cg[2]; cg[0] = ng[0]; cg[1] = ng[1];
                if (ai * 4 + m + 1 < 8) { const int q1 = ai * 4 + m + 1; const size_t rn = (size_t)(row0 + (q1 >> 2) * HALF + (q1 & 3) * 16);
#pragma unroll
                    for (int bj = 0; bj < 2; ++bj) ng[bj] = *(const u32x4*)(GB + rn * ldg + col0 + bj * HALF); }
#pragma unroll
                for (int bj = 0; bj < 2; ++bj) {
                    const u32x4 gb = cg[bj];
                    const float b_[8] = {bflo(gb.x), bfhi(gb.x), bflo(gb.y), bfhi(gb.y), bflo(gb.z), bfhi(gb.z), bflo(gb.w), bfhi(gb.w)};
                    float o[8];
#pragma unroll
                    for (int j = 0; j < 8; ++j) o[j] = acc[ai][bj][m][j >> 2][j & 3] * __builtin_amdgcn_rcpf(1.0f + e_neg(b_[j]));
                    u32x4 w; w.x = cvt_pk_bf16(o[0], o[1]); w.y = cvt_pk_bf16(o[2], o[3]); w.z = cvt_pk_bf16(o[4], o[5]); w.w = cvt_pk_bf16(o[6], o[7]);
                    *(u32x4*)(O + row * ldc + col0 + bj * HALF) = w;
                }
            }
    }
};

template <class Epi, class Sched, bool ALIGN_EPI = false, bool SP2 = false, bool I8 = false, bool TWOSEG = false>
__device__ __forceinline__ void gemm_phase(PG8_LAS unsigned char* lds, const Gemm g, const Sched& S, const Epi& E, const int wave_) {
    int lane_o_ = lane_id(); asm volatile("" : "+v"(lane_o_));
    const int lane = lane_o_, wid = wave_, tid = wid * 64 + lane, wr = wid >> 2, wc = wid & 3, fr = lane & 15, fq = lane >> 4;
    const int K = g.K, nt1 = K / BK, nt = TWOSEG ? 2 * nt1 : nt1;
    unsigned voffA[2], voffB[2];
#pragma unroll
    for (int i = 0; i < 2; ++i) { int R, C; stage_rc(tid * 16 + i * 8192, R, C); const int Rb = Epi::PERM ? ((R & ~31) + perm32(R & 31)) : R;
        voffA[i] = (unsigned)(R * g.lda + C) * 2u; voffB[i] = (unsigned)(Rb * K + C) * 2u; }
    const size_t kstep = (size_t)(BK * 2);
    const size_t hstep = (size_t)HALF * K * 2;
    const size_t tstep = 2 * hstep;
    const size_t hstepA = (size_t)HALF * g.lda * 2, tstepA = 2 * hstepA;
    const unsigned ldsw = (unsigned)wid * 1024u;
    const int aoff = lds_byte(wr * 64 + fr, fq * 8), boff = lds_byte(wc * 32 + fr, fq * 8);
#define PG8_SA(b, h) (((b) * 2 + (h)) * HTB)
#define PG8_SB(b, h) ((4 + (b) * 2 + (h)) * HTB)
#define PG8_STAGE(bufoff, gbase, voff) do { _Pragma("unroll") for (int _i = 0; _i < 2; ++_i) \
        __builtin_amdgcn_global_load_lds((const unsigned*)((const char*)(gbase) + (voff)[_i]), (PG8_LAS unsigned*)(lds + (bufoff) + ldsw + _i * 8192), 16, 0, 0); } while (0)
#define PG8_LDA(dst, b, h) do { _Pragma("unroll") for (int m = 0; m < 4; ++m) _Pragma("unroll") for (int k = 0; k < 2; ++k) dst[m][k] = *(const PG8_LAS bf16x8*)(lds + PG8_SA(b, h) + aoff + m * 2048 + k * 1024); } while (0)
#define PG8_LDB(dst, b, h) do { _Pragma("unroll") for (int n = 0; n < 2; ++n) _Pragma("unroll") for (int k = 0; k < 2; ++k) dst[n][k] = *(const PG8_LAS bf16x8*)(lds + PG8_SB(b, h) + boff + n * 2048 + k * 1024); } while (0)
#define PG8_MMA(ai, bj, At, Bt) do { __builtin_amdgcn_s_setprio(1); _Pragma("unroll") for (int m = 0; m < 4; ++m) _Pragma("unroll") for (int n = 0; n < 2; ++n) _Pragma("unroll") for (int k = 0; k < 2; ++k) { \
        if constexpr (I8) { typedef int v4i_ __attribute__((ext_vector_type(4))); \
            acc[ai][bj][m][n] = __builtin_bit_cast(f32x4, __builtin_amdgcn_mfma_i32_16x16x64_i8(__builtin_bit_cast(v4i_, Bt[n][k]), __builtin_bit_cast(v4i_, At[m][k]), __builtin_bit_cast(v4i_, acc[ai][bj][m][n]), 0, 0, 0)); } \
        else acc[ai][bj][m][n] = __builtin_amdgcn_mfma_f32_16x16x32_bf16(Bt[n][k], At[m][k], acc[ai][bj][m][n], 0, 0, 0); } \
        __builtin_amdgcn_s_setprio(0); } while (0)
#define PG8_WAIT_V(n) asm volatile("s_waitcnt vmcnt(" #n ")" ::: "memory")
#define PG8_WAIT_L(n) asm volatile("s_waitcnt lgkmcnt(" #n ")" ::: "memory")
#define PG8_BAR __builtin_amdgcn_s_barrier()
#define PG8_SCHED __builtin_amdgcn_sched_barrier(0)
    Unit cur, nxt; int ui = 0;
    if (!S.next(0, cur)) return;
    f32x4 acc[2][2][4][2];
#pragma unroll
    for (int a = 0; a < 2; ++a)
#pragma unroll
        for (int b = 0; b < 2; ++b)
#pragma unroll
            for (int m = 0; m < 4; ++m)
#pragma unroll
                for (int n = 0; n < 2; ++n) acc[a][b][m][n] = (f32x4){0.f, 0.f, 0.f, 0.f};
    bf16x8 At[4][2], B0[2][2], B1[2][2];
    const char* cA = (const char*)g.A + (size_t)cur.pm * tstepA; const char* cB = (const char*)g.Bt + (size_t)cur.pn * tstep;
    S.a_ready(cur);
    if constexpr (SP2) {
        PG8_STAGE(PG8_SB(0, 0), cB, voffB); PG8_STAGE(PG8_SB(0, 1), cB + hstep, voffB); PG8_STAGE(PG8_SA(0, 0), cA, voffA); PG8_STAGE(PG8_SA(0, 1), cA + hstepA, voffA);
        if (wr == 1) PG8_BAR;
        PG8_WAIT_V(2); PG8_BAR;
        PG8_STAGE(PG8_SB(1, 0), cB + kstep, voffB); PG8_STAGE(PG8_SA(1, 0), cA + kstep, voffA); PG8_STAGE(PG8_SB(1, 1), cB + hstep + kstep, voffB);
        PG8_WAIT_V(6); PG8_BAR;
    } else {
        PG8_STAGE(PG8_SB(0, 0), cB, voffB); PG8_STAGE(PG8_SA(0, 0), cA, voffA); PG8_STAGE(PG8_SB(0, 1), cB + hstep, voffB); PG8_STAGE(PG8_SA(0, 1), cA + hstepA, voffA);
        if (wr == 1) PG8_BAR;
        PG8_WAIT_V(4); PG8_BAR;
        PG8_STAGE(PG8_SB(1, 0), cB + kstep, voffB); PG8_STAGE(PG8_SA(1, 0), cA + kstep, voffA); PG8_STAGE(PG8_SB(1, 1), cB + hstep + kstep, voffB);
        PG8_WAIT_V(6); PG8_BAR;
    }
    for (;;) {
        const bool has_next = S.next(ui + 1, nxt);
        const char* nA = has_next ? (const char*)g.A + (size_t)nxt.pm * tstepA : cA; const char* nB = has_next ? (const char*)g.Bt + (size_t)nxt.pn * tstep : cB;
        const char* cA2 = cA; const char* cB2 = cB;
        if constexpr (TWOSEG) { cA2 = (const char*)g.A2 + (size_t)cur.pm * tstepA - (size_t)nt1 * kstep; cB2 = (const char*)g.Bt2 + (size_t)cur.pn * tstep - (size_t)nt1 * kstep; }
        for (int t = 0; t < nt; t += 2) {
            const bool last = (t == nt - 2);
            const char* sA = cA; const char* sB = cB; const char* sA2 = cA; const char* sB2 = cB;
            if constexpr (TWOSEG) { if (t >= nt1) { sA = cA2; sB = cB2; } if (t + 2 >= nt1) { sA2 = cA2; sB2 = cB2; } if (t == nt1) E.mid(acc, cur, wr, wc, fr, fq); }
            (void)sB;
            const char* a1 = sA + (size_t)(t + 1) * kstep;
            const char* a2 = last ? nA : sA2 + (size_t)(t + 2) * kstep; const char* b2 = last ? nB : sB2 + (size_t)(t + 2) * kstep;
            const char* a3 = a2 + kstep; const char* b3 = b2 + kstep;
            if (last && has_next) S.a_ready(nxt);
            if constexpr (SP2) {
            PG8_LDB(B0, 0, 0); PG8_LDB(B1, 0, 1); PG8_SCHED; PG8_LDA(At, 0, 0); PG8_STAGE(PG8_SA(1, 1), a1 + hstepA, voffA);
            PG8_WAIT_V(8); PG8_WAIT_L(0); PG8_BAR; PG8_MMA(0, 0, At, B0); PG8_MMA(0, 1, At, B1); PG8_BAR; PG8_SCHED;
            PG8_LDA(At, 0, 1); PG8_STAGE(PG8_SB(0, 0), b2, voffB); PG8_STAGE(PG8_SB(0, 1), b2 + hstep, voffB); PG8_STAGE(PG8_SA(0, 0), a2, voffA);
            PG8_WAIT_V(8); PG8_WAIT_L(0); PG8_BAR; PG8_MMA(1, 0, At, B0); PG8_MMA(1, 1, At, B1); PG8_BAR; PG8_SCHED;
            PG8_LDB(B0, 1, 0); PG8_LDB(B1, 1, 1); PG8_SCHED; PG8_LDA(At, 1, 0); PG8_STAGE(PG8_SA(0, 1), a2 + hstepA, voffA);
            PG8_WAIT_V(8); PG8_WAIT_L(0); PG8_BAR; PG8_MMA(0, 0, At, B0); PG8_MMA(0, 1, At, B1); PG8_BAR; PG8_SCHED;
            PG8_LDA(At, 1, 1); PG8_STAGE(PG8_SB(1, 0), b3, voffB); PG8_STAGE(PG8_SB(1, 1), b3 + hstep, voffB); PG8_STAGE(PG8_SA(1, 0), a3, voffA);
            PG8_WAIT_V(8); PG8_WAIT_L(0); PG8_BAR; PG8_MMA(1, 0, At, B0); PG8_MMA(1, 1, At, B1); PG8_BAR; PG8_SCHED;
            } else {
            PG8_LDB(B0, 0, 0); PG8_SCHED; PG8_LDA(At, 0, 0); PG8_STAGE(PG8_SA(1, 1), a1 + hstepA, voffA);
            PG8_WAIT_L(8); PG8_BAR; PG8_WAIT_L(0); PG8_MMA(0, 0, At, B0); PG8_BAR; PG8_SCHED;
            PG8_LDB(B1, 0, 1); PG8_STAGE(PG8_SB(0, 0), b2, voffB);
            PG8_BAR; PG8_WAIT_L(0); PG8_MMA(0, 1, At, B1); PG8_BAR;
            PG8_LDA(At, 0, 1); PG8_STAGE(PG8_SA(0, 0), a2, voffA);
            PG8_BAR; PG8_WAIT_L(0); PG8_MMA(1, 0, At, B0); PG8_BAR; PG8_SCHED;
            PG8_STAGE(PG8_SB(0, 1), b2 + hstep, voffB);
            PG8_WAIT_V(6); PG8_BAR; PG8_MMA(1, 1, At, B1); PG8_BAR;
            PG8_LDB(B0, 1, 0); PG8_SCHED; PG8_LDA(At, 1, 0); PG8_STAGE(PG8_SA(0, 1), a2 + hstepA, voffA);
            PG8_WAIT_L(8); PG8_BAR; PG8_WAIT_L(0); PG8_MMA(0, 0, At, B0); PG8_BAR; PG8_SCHED;
            PG8_LDB(B1, 1, 1); PG8_STAGE(PG8_SB(1, 0), b3, voffB);
            PG8_BAR; PG8_WAIT_L(0); PG8_MMA(0, 1, At, B1); PG8_BAR;
            PG8_LDA(At, 1, 1); PG8_STAGE(PG8_SA(1, 0), a3, voffA);
            PG8_BAR; PG8_WAIT_L(0); PG8_MMA(1, 0, At, B0); PG8_BAR; PG8_SCHED;
            PG8_STAGE(PG8_SB(1, 1), b3 + hstep, voffB);
            PG8_WAIT_V(6); PG8_BAR; PG8_MMA(1, 1, At, B1); PG8_BAR;
            }
        }
        if constexpr (ALIGN_EPI) { if (wr == 0) PG8_BAR; }
        if constexpr (!Epi::AFTER_DRAIN) { E(acc, cur, wr, wc, fr, fq); S.done(cur); }
        if (!has_next) break;
#pragma unroll
        for (int a = 0; a < 2; ++a)
#pragma unroll
            for (int b = 0; b < 2; ++b)
#pragma unroll
                for (int m = 0; m < 4; ++m)
#pragma unroll
                    for (int n = 0; n < 2; ++n) acc[a][b][m][n] = (f32x4){0.f, 0.f, 0.f, 0.f};
        cur = nxt; cA = nA; cB = nB; ++ui;
        if constexpr (ALIGN_EPI) { if (wr == 1) PG8_BAR; }
    }
    PG8_WAIT_V(0);
    if constexpr (!ALIGN_EPI) { if (wr == 0) PG8_BAR; }
    PG8_BAR;
    if constexpr (Epi::AFTER_DRAIN) { E.fused(acc, cur, wr, wc, fr, fq, lds, wid, lane); S.done(cur); }
#undef PG8_SA
#undef PG8_SB
#undef PG8_STAGE
#undef PG8_LDA
#undef PG8_LDB
#undef PG8_MMA
#undef PG8_WAIT_V
#undef PG8_WAIT_L
#undef PG8_BAR
#undef PG8_SCHED
}
}

constexpr int NWAVES = 8;
constexpr int BATCH = 32, SEQ = 2048, D = 1024, FF = 2816, M = BATCH * SEQ;
constexpr int NMOD = 9, MODW = NMOD * D;
constexpr int INW = 4036, PW = 4096;
constexpr int PC_CQ = 0, PC_CKV = 256, PC_KIDX = 384, PC_WIDX = 448, PC_MQ = 512, PC_MK = 1024, PC_MV = 1536, PC_GA = 2048, PC_GB = 3072;
constexpr float EPS = 1e-6f, LOG2E = 1.4426950408889634f;
constexpr int NPHASE = 16;
#ifndef MK_ONE_LAUNCH
#define MK_ONE_LAUNCH 1
#endif
#ifndef PROBE_VARIANTS
#define PROBE_VARIANTS 0
#endif

constexpr size_t MiB = 1u << 20;
constexpr size_t WS_CTL = 0, CTL_ZERO_BYTES = 1 * MiB;
constexpr size_t WS_MODS = 1 * MiB;
constexpr size_t WS_WT1A = 4 * MiB, WS_W2TA = 15 * MiB, WS_WT1B = 21 * MiB, WS_W2TB = 32 * MiB, WS_WIN = 38 * MiB, WS_WQ = 46 * MiB, WS_WC = 47 * MiB, WS_WPM = 49 * MiB, WS_WOUT = 50 * MiB;
constexpr size_t WS_CQN = 52 * MiB, WS_CKVN = 84 * MiB, WS_KIDXN = 100 * MiB, WS_WIDX = 108 * MiB, WS_QIDX = 110 * MiB, WS_OMOBA = 142 * MiB;
constexpr size_t WS_XN = 206 * MiB;
constexpr size_t WS_OLAT = 334 * MiB;
constexpr size_t WS_P = 462 * MiB;
constexpr size_t WS_MASK = 974 * MiB;
constexpr size_t WS_KMG = 990 * MiB;
constexpr size_t WS_END = 991 * MiB;
constexpr int CW_BAR = 4096;

constexpr int LDSCTL_OFF = 140288, MISC_OFF = LDSCTL_OFF + 320;
constexpr int LDS_BYTES = 147456;
static_assert(MISC_OFF + 128 <= LDS_BYTES, "LDS map");

#define GAS __attribute__((address_space(1)))
#define LAS __attribute__((address_space(3)))
typedef unsigned short bf16;
typedef unsigned v4u __attribute__((ext_vector_type(4)));
typedef unsigned v2u __attribute__((ext_vector_type(2)));
typedef float f32x4 __attribute__((ext_vector_type(4)));
typedef float f32x16 __attribute__((ext_vector_type(16)));
typedef short bf16x8 __attribute__((ext_vector_type(8)));
typedef short s16x4 __attribute__((ext_vector_type(4)));
typedef short v4i16_t __attribute__((ext_vector_type(4)));
typedef GAS unsigned gu32;
#define RLX_AGENT __ATOMIC_RELAXED, __HIP_MEMORY_SCOPE_AGENT
#define LDS_WAIT() asm volatile("s_waitcnt lgkmcnt(0)" ::: "memory")
__device__ __forceinline__ unsigned f2bf(float f) { unsigned u = __builtin_bit_cast(unsigned, f); return (u + 0x7fffu + ((u >> 16) & 1u)) >> 16; }
__device__ __forceinline__ unsigned pk2(float lo, float hi) { return f2bf(lo) | (f2bf(hi) << 16); }
__device__ __forceinline__ float bf2f(bf16 v) { return __uint_as_float((unsigned)v << 16); }
__device__ __forceinline__ float wlo(unsigned w) { return __uint_as_float(w << 16); }
__device__ __forceinline__ float whi(unsigned w) { return __uint_as_float(w & 0xffff0000u); }
typedef float f32x2_t __attribute__((ext_vector_type(2))); typedef __bf16 bf16x2_t __attribute__((ext_vector_type(2)));
__device__ __forceinline__ unsigned cvtpk(float lo, float hi) { f32x2_t v = {lo, hi}; bf16x2_t b = __builtin_convertvector(v, bf16x2_t); return __builtin_bit_cast(unsigned, b); }
__device__ __forceinline__ float wave_sum(float v) {
#pragma unroll
    for (int o = 1; o < 64; o <<= 1) v += __shfl_xor(v, o);
    return v;
}

#define XB_TMO      128
#define XB_XCNT(j)  (256  + 64 * (j))
#define XB_XSUB(j)  (1280 + 64 * (j))
#define XB_XGEN(j)  (2304 + 64 * (j))
#define XB_TOP      3328
#define XB_TOPGEN   3392
#define XCD_BAR_WORDS 3456
#define XB_SPIN_CAP (1u << 18)

__device__ __forceinline__ unsigned xb_ld(unsigned* p)              { return __hip_atomic_load(p, __ATOMIC_RELAXED, __HIP_MEMORY_SCOPE_AGENT); }
__device__ __forceinline__ unsigned xb_add(unsigned* p, unsigned v) { return __hip_atomic_fetch_add(p, v, __ATOMIC_RELAXED, __HIP_MEMORY_SCOPE_AGENT); }
__device__ __forceinline__ unsigned xb_xcc_id() { return (unsigned)__builtin_amdgcn_s_getreg((3 << 11) | 20) & 0xFu; }
#define XB_SPIN(cond, bar) do { unsigned _sp = 0; while (cond) { __builtin_amdgcn_s_sleep(1); \
    if ((++_sp & 255u) == 0u) { if (xb_ld(&(bar)[XB_TMO])) break; if (_sp > XB_SPIN_CAP) { atomicAdd(&(bar)[XB_TMO], 1u); break; } } } } while (0)

struct XcdBarrier {
    unsigned* bar; unsigned x;
    volatile LAS unsigned* st;
};

__device__ __forceinline__ XcdBarrier xcd_barrier_post(unsigned* bar, volatile LAS unsigned* st) {
    XcdBarrier b; b.bar = bar; b.x = xb_xcc_id(); b.st = st;
    if (threadIdx.x == 0) (void)xb_add(&bar[XB_XCNT(b.x)], 1u);
    return b;
}
__device__ __forceinline__ void xcd_barrier_complete(unsigned* bar, unsigned x, unsigned& nloc, unsigned& nx) {
    const unsigned G = gridDim.x * gridDim.y * gridDim.z;
    unsigned sum, cnt, mine, sp = 0u;
    for (;;) {
        sum = 0u; cnt = 0u; mine = 0u;
#pragma unroll
        for (unsigned j = 0; j < 16; ++j) { const unsigned c = xb_ld(&bar[XB_XCNT(j)]); sum += c; cnt += (c > 0u) ? 1u : 0u; mine = (j == x) ? c : mine; }
        if (sum == G) break;
        __builtin_amdgcn_s_sleep(1);
        if ((++sp & 255u) == 0u) { if (xb_ld(&bar[XB_TMO])) break; if (sp > XB_SPIN_CAP) { atomicAdd(&bar[XB_TMO], 1u); break; } }
    }
    nloc = mine > 0u ? mine : 1u; nx = cnt > 0u ? cnt : 1u;
}

__device__ __forceinline__ void xcd_barrier(const XcdBarrier& b) {
    asm volatile("s_waitcnt vmcnt(0)" ::: "memory");
    __syncthreads();
    if (threadIdx.x == 0) {
        unsigned* bar = b.bar;
        __builtin_amdgcn_s_waitcnt(0);
        unsigned nloc = b.st[0], nx = b.st[1];
        if (nloc == 0u) { xcd_barrier_complete(bar, b.x, nloc, nx); b.st[0] = nloc; b.st[1] = nx; }
        const unsigned old = xb_add(&bar[XB_XSUB(b.x)], 1u);
        const unsigned gen = old / nloc;
        if (old + 1u == (gen + 1u) * nloc) {
            __builtin_amdgcn_fence(__ATOMIC_RELEASE, "agent");
            asm volatile("s_waitcnt vmcnt(0)" ::: "memory");
            const unsigned og = xb_add(&bar[XB_TOP], 1u);
            const unsigned tg = og / nx;
            if (og + 1u == (tg + 1u) * nx) xb_add(&bar[XB_TOPGEN], 1u);
            else XB_SPIN(xb_ld(&bar[XB_TOPGEN]) == tg, bar);
            __builtin_amdgcn_fence(__ATOMIC_ACQUIRE, "agent");
            xb_add(&bar[XB_XGEN(b.x)], 1u);
            asm volatile("s_waitcnt vmcnt(0)" ::: "memory");
        } else {
            XB_SPIN(xb_ld(&bar[XB_XGEN(b.x)]) == gen, bar);
            __builtin_amdgcn_fence(__ATOMIC_ACQUIRE, "agent");
            asm volatile("s_waitcnt vmcnt(0)" ::: "memory");
        }
    }
    __syncthreads();
}


__device__ __forceinline__ void grp_barrier(unsigned* bar, unsigned* cnt, unsigned target, bool pure) {
    asm volatile("s_waitcnt vmcnt(0)" ::: "memory");
    __syncthreads();
    if (threadIdx.x == 0) {
        __builtin_amdgcn_s_waitcnt(0);
        if (!pure) { __builtin_amdgcn_fence(__ATOMIC_RELEASE, "agent"); asm volatile("s_waitcnt vmcnt(0)" ::: "memory"); }
        (void)xb_add(cnt, 1u);
        XB_SPIN(xb_ld(cnt) < target, bar);
        __builtin_amdgcn_fence(__ATOMIC_ACQUIRE, "agent");
        asm volatile("s_waitcnt vmcnt(0)" ::: "memory");
    }
    __syncthreads();
}

__device__ __forceinline__ void tr_item(const float* W, int N, int c0, int nvalid, int k0, bf16* WT, int ldk, int drow0, LAS float* scr, int lane, float scale = 1.0f) {
#pragma unroll
    for (int i = 0; i < 32; ++i) { const int kk = 2 * i + (lane >> 5), n = lane & 31; scr[kk * 33 + n] = (n < nvalid) ? W[(size_t)(k0 + kk) * N + c0 + n] * scale : 0.f; }
    LDS_WAIT(); asm volatile("" ::: "memory");
    const int c = lane & 7;
#pragma unroll
    for (int j = 0; j < 4; ++j) { const int n = (lane >> 3) + 8 * j; const LAS float* s = scr + (8 * c) * 33 + n;
        v4u o; o.x = pk2(s[0 * 33], s[1 * 33]); o.y = pk2(s[2 * 33], s[3 * 33]); o.z = pk2(s[4 * 33], s[5 * 33]); o.w = pk2(s[6 * 33], s[7 * 33]);
        *(GAS v4u*)(WT + (size_t)(drow0 + n) * ldk + k0 + 8 * c) = o; }
    LDS_WAIT(); asm volatile("" ::: "memory");
}

__device__ __forceinline__ unsigned pk4_i8(float a, float b, float c, float d) {
    const int i0 = (int)__builtin_rintf(a), i1 = (int)__builtin_rintf(b), i2 = (int)__builtin_rintf(c), i3 = (int)__builtin_rintf(d);
    return ((unsigned)i0 & 0xffu) | (((unsigned)i1 & 0xffu) << 8) | (((unsigned)i2 & 0xffu) << 16) | ((unsigned)i3 << 24);
}
__device__ __forceinline__ void colmax_item(const float* W, int N, int c0, int k0, unsigned* CMAX, int drow0, int lane, int nvalid = 32, unsigned long long* CSQ = nullptr) {
    float mx = 0.f, sq = 0.f;
#pragma unroll
    for (int i = 0; i < 32; ++i) { const int kk = 2 * i + (lane >> 5), n = lane & 31; if (n < nvalid) { const float w = W[(size_t)(k0 + kk) * N + c0 + n]; mx = fmaxf(mx, fabsf(w)); sq += w * w; } }
    mx = fmaxf(mx, __shfl_xor(mx, 32));
    if (lane < 32) atomicMax(CMAX + drow0 + lane, __float_as_uint(mx));
    if (CSQ) { sq += __shfl_xor(sq, 32); if (lane < 32) atomicAdd(CSQ + drow0 + lane, (unsigned long long)(sq * 4294967296.0f)); }
}
__device__ __forceinline__ void tr_item_q8(const float* W, int N, int c0, int k0, unsigned char* WT8, int ldk, int drow0, const unsigned* CMAX, LAS float* scr, int lane, int nvalid = 32, const unsigned long long* CSQ = nullptr, float cminv = 1.0f) {
    const float cm = __uint_as_float(CMAX[drow0 + (lane & 31)]); const float qs = cm > 0.f ? 127.0f / cm : 0.f;
    float ck = 1.0f;
    if (CSQ) { const int k = k0 + lane, r1 = (k >> 7) * 256 + (k & 127); ck = __builtin_sqrtf(((float)CSQ[r1] * 2.3283064365386963e-10f) * ((float)CSQ[r1 + 128] * 2.3283064365386963e-10f)) * cminv; }
#pragma unroll
    for (int i = 0; i < 32; ++i) { const int kk = 2 * i + (lane >> 5), n = lane & 31; float w = (n < nvalid) ? W[(size_t)(k0 + kk) * N + c0 + n] * qs : 0.f; if (CSQ) w *= __shfl(ck, kk); scr[kk * 33 + n] = w; }
    LDS_WAIT(); asm volatile("" ::: "memory");
    const int c = lane & 7;
#pragma unroll
    for (int j = 0; j < 4; ++j) { const int n = (lane >> 3) + 8 * j; const LAS float* sp = scr + (8 * c) * 33 + n;
        v2u o; o.x = pk4_i8(sp[0 * 33], sp[1 * 33], sp[2 * 33], sp[3 * 33]); o.y = pk4_i8(sp[4 * 33], sp[5 * 33], sp[6 * 33], sp[7 * 33]);
        *(GAS v2u*)(WT8 + (size_t)(drow0 + n) * ldk + k0 + 8 * c) = o; }
    LDS_WAIT(); asm volatile("" ::: "memory");
}
template <bool I8 = false>
__device__ __forceinline__ void normmod_phase(const float* xin, const float* g, const float* sh, const float* sc, bf16* xo, float* rsc, float* r2, int rbase, int rows, int lw, int nlw, int lane) {
    for (int row0 = rbase + lw * 32; row0 < rbase + rows; row0 += nlw * 32) {
        const int b = row0 >> 11;
        f32x4 A[4], Bv[4];
#pragma unroll
        for (int j = 0; j < 4; ++j) { const int col = 4 * lane + 256 * j; const f32x4 gv = *(const f32x4*)(g + col), sv = *(const f32x4*)(sc + (size_t)b * MODW + col); A[j] = gv * (sv + 1.0f); Bv[j] = *(const f32x4*)(sh + (size_t)b * MODW + col); }
        for (int rr = 0; rr < 32; rr += 4) {
            f32x4 v[4][4]; float s[4];
#pragma unroll
            for (int q = 0; q < 4; ++q) { const GAS f32x4* xr = (const GAS f32x4*)(xin + (size_t)(row0 + rr + q) * D) + lane;
#pragma unroll
                for (int j = 0; j < 4; ++j) v[q][j] = xr[64 * j]; }
#pragma unroll
            for (int q = 0; q < 4; ++q) { float t = 0.f;
#pragma unroll
                for (int j = 0; j < 4; ++j) t += (v[q][j].x * v[q][j].x + v[q][j].y * v[q][j].y) + (v[q][j].z * v[q][j].z + v[q][j].w * v[q][j].w);
                s[q] = t; }
#pragma unroll
            for (int o = 1; o < 64; o <<= 1) {
#pragma unroll
                for (int q = 0; q < 4; ++q) s[q] += __shfl_xor(s[q], o); }
#pragma unroll
            for (int q = 0; q < 4; ++q) { const float rs = __builtin_amdgcn_rsqf(s[q] * (1.0f / D) + EPS);
#pragma unroll
                for (int j = 0; j < 4; ++j) v[q][j] = v[q][j] * rs * A[j] + Bv[j]; }
            if (I8) {
                float mx[4];
#pragma unroll
                for (int q = 0; q < 4; ++q) { float t = 0.f;
#pragma unroll
                    for (int j = 0; j < 4; ++j) t = fmaxf(fmaxf(t, fmaxf(fabsf(v[q][j].x), fabsf(v[q][j].y))), fmaxf(fabsf(v[q][j].z), fabsf(v[q][j].w)));
                    mx[q] = t; }
#pragma unroll
                for (int o = 1; o < 64; o <<= 1) {
#pragma unroll
                    for (int q = 0; q < 4; ++q) mx[q] = fmaxf(mx[q], __shfl_xor(mx[q], o)); }
#pragma unroll
                for (int q = 0; q < 4; ++q) { const float qs = mx[q] > 0.f ? 127.0f / mx[q] : 0.f;
                    GAS unsigned* o4 = (GAS unsigned*)((unsigned char*)xo + (size_t)(row0 + rr + q) * D) + lane;
#pragma unroll
                    for (int j = 0; j < 4; ++j) o4[64 * j] = pk4_i8(v[q][j].x * qs, v[q][j].y * qs, v[q][j].z * qs, v[q][j].w * qs);
                    if (lane == 0) rsc[row0 + rr + q] = mx[q] * (1.0f / 127.0f); }
                if (r2) {
                    float sq[4];
#pragma unroll
                    for (int q = 0; q < 4; ++q) { float t = 0.f;
#pragma unroll
                        for (int j = 0; j < 4; ++j) t += (v[q][j].x * v[q][j].x + v[q][j].y * v[q][j].y) + (v[q][j].z * v[q][j].z + v[q][j].w * v[q][j].w);
                        sq[q] = t; }
#pragma unroll
                    for (int o = 1; o < 64; o <<= 1) {
#pragma unroll
                        for (int q = 0; q < 4; ++q) sq[q] += __shfl_xor(sq[q], o); }
                    if (lane == 0) {
#pragma unroll
                        for (int q = 0; q < 4; ++q) r2[row0 + rr + q] = sq[q] * (1.0f / D); }
                }
            } else {
#pragma unroll
                for (int q = 0; q < 4; ++q) { GAS v2u* o8 = (GAS v2u*)(xo + (size_t)(row0 + rr + q) * D) + lane;
#pragma unroll
                    for (int j = 0; j < 4; ++j) { const f32x4 o = v[q][j]; v2u w; w.x = cvtpk(o.x, o.y); w.y = cvtpk(o.z, o.w); o8[64 * j] = w; } }
            }
        }
    }
}
template <bool I8 = false>
__device__ __forceinline__ void normmod_bf_phase(const bf16* xin, const float* g, const float* sh, const float* sc, bf16* xo, float* rsc, float* r2, int rbase, int rows, int lw, int nlw, int lane) {
    for (int row0 = rbase + lw * 32; row0 < rbase + rows; row0 += nlw * 32) {
        const int b = row0 >> 11;
        f32x4 A[4], Bv[4];
#pragma unroll
        for (int j = 0; j < 4; ++j) { const int col = 4 * lane + 256 * j; const f32x4 gv = *(const f32x4*)(g + col), sv = *(const f32x4*)(sc + (size_t)b * MODW + col); A[j] = gv * (sv + 1.0f); Bv[j] = *(const f32x4*)(sh + (size_t)b * MODW + col); }
        for (int rr = 0; rr < 32; rr += 4) {
            v2u w[4][4]; float s[4];
#pragma unroll
            for (int q = 0; q < 4; ++q) { const GAS v2u* xr = (const GAS v2u*)(xin + (size_t)(row0 + rr + q) * D) + lane;
#pragma unroll
                for (int j = 0; j < 4; ++j) w[q][j] = xr[64 * j]; }
#pragma unroll
            for (int q = 0; q < 4; ++q) { float t = 0.f;
#pragma unroll
                for (int j = 0; j < 4; ++j) { const float a0 = wlo(w[q][j].x), a1 = whi(w[q][j].x), a2 = wlo(w[q][j].y), a3 = whi(w[q][j].y); t += (a0 * a0 + a1 * a1) + (a2 * a2 + a3 * a3); }
                s[q] = t; }
#pragma unroll
            for (int o = 1; o < 64; o <<= 1) {
#pragma unroll
                for (int q = 0; q < 4; ++q) s[q] += __shfl_xor(s[q], o); }
            f32x4 v[4][4];
#pragma unroll
            for (int q = 0; q < 4; ++q) { const float rs = __builtin_amdgcn_rsqf(s[q] * (1.0f / D) + EPS);
#pragma unroll
                for (int j = 0; j < 4; ++j) v[q][j] = (f32x4){wlo(w[q][j].x), whi(w[q][j].x), wlo(w[q][j].y), whi(w[q][j].y)} * rs * A[j] + Bv[j]; }
            if (I8) {
                float mx[4];
#pragma unroll
                for (int q = 0; q < 4; ++q) { float t = 0.f;
#pragma unroll
                    for (int j = 0; j < 4; ++j) t = fmaxf(fmaxf(t, fmaxf(fabsf(v[q][j].x), fabsf(v[q][j].y))), fmaxf(fabsf(v[q][j].z), fabsf(v[q][j].w)));
                    mx[q] = t; }
#pragma unroll
                for (int o = 1; o < 64; o <<= 1) {
#pragma unroll
                    for (int q = 0; q < 4; ++q) mx[q] = fmaxf(mx[q], __shfl_xor(mx[q], o)); }
#pragma unroll
                for (int q = 0; q < 4; ++q) { const float qs = mx[q] > 0.f ? 127.0f / mx[q] : 0.f;
                    GAS unsigned* o4 = (GAS unsigned*)((unsigned char*)xo + (size_t)(row0 + rr + q) * D) + lane;
#pragma unroll
                    for (int j = 0; j < 4; ++j) o4[64 * j] = pk4_i8(v[q][j].x * qs, v[q][j].y * qs, v[q][j].z * qs, v[q][j].w * qs);
                    if (lane == 0) rsc[row0 + rr + q] = mx[q] * (1.0f / 127.0f); }
                if (r2) {
                    float sq[4];
#pragma unroll
                    for (int q = 0; q < 4; ++q) { float t = 0.f;
#pragma unroll
                        for (int j = 0; j < 4; ++j) t += (v[q][j].x * v[q][j].x + v[q][j].y * v[q][j].y) + (v[q][j].z * v[q][j].z + v[q][j].w * v[q][j].w);
                        sq[q] = t; }
#pragma unroll
                    for (int o = 1; o < 64; o <<= 1) {
#pragma unroll
                        for (int q = 0; q < 4; ++q) sq[q] += __shfl_xor(sq[q], o); }
                    if (lane == 0) {
#pragma unroll
                        for (int q = 0; q < 4; ++q) r2[row0 + rr + q] = sq[q] * (1.0f / D); }
                }
            } else {
#pragma unroll
                for (int q = 0; q < 4; ++q) { GAS v2u* o8 = (GAS v2u*)(xo + (size_t)(row0 + rr + q) * D) + lane;
#pragma unroll
                    for (int j = 0; j < 4; ++j) { const f32x4 o = v[q][j]; v2u ww; ww.x = cvtpk(o.x, o.y); ww.y = cvtpk(o.z, o.w); o8[64 * j] = ww; } }
            }
        }
    }
}
__device__ __forceinline__ void finalnorm_phase(const bf16* xin, const float* g, float* out, int gw, int NGW, int lane) {
    f32x4 A[4];
#pragma unroll
    for (int j = 0; j < 4; ++j) A[j] = *(const f32x4*)(g + 4 * lane + 256 * j);
    for (int row0 = 4 * gw; row0 < M; row0 += 4 * NGW) {
        v2u w[4][4]; float s[4];
#pragma unroll
        for (int q = 0; q < 4; ++q) { const GAS v2u* xr = (const GAS v2u*)(xin + (size_t)(row0 + q) * D) + lane;
#pragma unroll
            for (int j = 0; j < 4; ++j) w[q][j] = xr[64 * j]; }
#pragma unroll
        for (int q = 0; q < 4; ++q) { float t = 0.f;
#pragma unroll
            for (int j = 0; j < 4; ++j) { const float a0 = wlo(w[q][j].x), a1 = whi(w[q][j].x), a2 = wlo(w[q][j].y), a3 = whi(w[q][j].y); t += (a0 * a0 + a1 * a1) + (a2 * a2 + a3 * a3); }
            s[q] = t; }
#pragma unroll
        for (int o = 1; o < 64; o <<= 1) {
#pragma unroll
            for (int q = 0; q < 4; ++q) s[q] += __shfl_xor(s[q], o); }
#pragma unroll
        for (int q = 0; q < 4; ++q) { const float rs = __builtin_amdgcn_rsqf(s[q] * (1.0f / D) + EPS);
            GAS f32x4* orow = (GAS f32x4*)(out + (size_t)(row0 + q) * D) + lane;
#pragma unroll
            for (int j = 0; j < 4; ++j) { const f32x4 v = (f32x4){wlo(w[q][j].x), whi(w[q][j].x), wlo(w[q][j].y), whi(w[q][j].y)}; orow[64 * j] = v * rs * A[j]; } }
    }
}
__device__ __forceinline__ void uquant_phase(const bf16* U, unsigned char* U8, float* rsc, int gw, int NGW, int lane) {
    for (int row0 = 2 * gw; row0 < M; row0 += 2 * NGW) {
        v2u w[2][11]; float mx[2];
#pragma unroll
        for (int q = 0; q < 2; ++q) { const GAS v2u* ur = (const GAS v2u*)(U + (size_t)(row0 + q) * FF) + lane;
#pragma unroll
            for (int j = 0; j < 11; ++j) w[q][j] = ur[64 * j]; }
#pragma unroll
        for (int q = 0; q < 2; ++q) { float t = 0.f;
#pragma unroll
            for (int j = 0; j < 11; ++j) t = fmaxf(fmaxf(t, fmaxf(fabsf(wlo(w[q][j].x)), fabsf(whi(w[q][j].x)))), fmaxf(fabsf(wlo(w[q][j].y)), fabsf(whi(w[q][j].y))));
            mx[q] = t; }
#pragma unroll
        for (int o = 1; o < 64; o <<= 1) { mx[0] = fmaxf(mx[0], __shfl_xor(mx[0], o)); mx[1] = fmaxf(mx[1], __shfl_xor(mx[1], o)); }
#pragma unroll
        for (int q = 0; q < 2; ++q) { const float qs = mx[q] > 0.f ? 127.0f / mx[q] : 0.f;
            GAS unsigned* o4 = (GAS unsigned*)(U8 + (size_t)(row0 + q) * FF) + lane;
#pragma unroll
            for (int j = 0; j < 11; ++j) o4[64 * j] = pk4_i8(wlo(w[q][j].x) * qs, whi(w[q][j].x) * qs, wlo(w[q][j].y) * qs, whi(w[q][j].y) * qs);
            if (lane == 0) rsc[row0 + q] = mx[q] * (1.0f / 127.0f); }
    }
}
__device__ __forceinline__ void smallnorm_phase(const bf16* P, const float* g_cq, const float* g_ckv, const float* g_kidx, const float* b_kidx,
                                                bf16* CQN, bf16* CKVN, bf16* KIDXN, float* WIDX, int rbase, int rows, int lw, int nlw, int lane) {
    const f32x4 gq = *(const f32x4*)(g_cq + 4 * lane);
    const float gk0 = g_ckv[2 * lane], gk1 = g_ckv[2 * lane + 1], gi = g_kidx[lane], bi = b_kidx[lane];
    for (int row0 = rbase + 4 * lw; row0 < rbase + rows; row0 += 4 * nlw) {
        v2u wq[4]; unsigned wk[4]; bf16 wi[4]; bf16 ww[4];
#pragma unroll
        for (int q = 0; q < 4; ++q) { const bf16* pr = P + (size_t)(row0 + q) * PW;
            wq[q] = *(const v2u*)(pr + PC_CQ + 4 * lane); wk[q] = *(const unsigned*)(pr + PC_CKV + 2 * lane); wi[q] = pr[PC_KIDX + lane]; ww[q] = pr[PC_WIDX + (lane & 3)]; }
        float sq[4], sk[4], si[4];
#pragma unroll
        for (int q = 0; q < 4; ++q) { const float q0 = wlo(wq[q].x), q1 = whi(wq[q].x), q2 = wlo(wq[q].y), q3 = whi(wq[q].y), k0 = wlo(wk[q]), k1 = whi(wk[q]);
            sq[q] = (q0 * q0 + q1 * q1) + (q2 * q2 + q3 * q3); sk[q] = k0 * k0 + k1 * k1; si[q] = bf2f(wi[q]); }
#pragma unroll
        for (int o = 1; o < 64; o <<= 1) {
#pragma unroll
            for (int q = 0; q < 4; ++q) { sq[q] += __shfl_xor(sq[q], o); sk[q] += __shfl_xor(sk[q], o); si[q] += __shfl_xor(si[q], o); } }
        float xc[4], sv[4];
#pragma unroll
        for (int q = 0; q < 4; ++q) { xc[q] = bf2f(wi[q]) - si[q] * (1.0f / 64.0f); sv[q] = xc[q] * xc[q]; }
#pragma unroll
        for (int o = 1; o < 64; o <<= 1) {
#pragma unroll
            for (int q = 0; q < 4; ++q) sv[q] += __shfl_xor(sv[q], o); }
#pragma unroll
        for (int q = 0; q < 4; ++q) { const size_t row = (size_t)(row0 + q);
            const float rq = __builtin_amdgcn_rsqf(sq[q] * (1.0f / 256.0f) + EPS), rk = __builtin_amdgcn_rsqf(sk[q] * (1.0f / 128.0f) + EPS), ri = __builtin_amdgcn_rsqf(sv[q] * (1.0f / 64.0f) + EPS);
            const float q0 = wlo(wq[q].x), q1 = whi(wq[q].x), q2 = wlo(wq[q].y), q3 = whi(wq[q].y), k0 = wlo(wk[q]), k1 = whi(wk[q]);
            v2u oq; oq.x = cvtpk(q0 * rq * gq.x, q1 * rq * gq.y); oq.y = cvtpk(q2 * rq * gq.z, q3 * rq * gq.w);
            *(v2u*)(CQN + row * 256 + 4 * lane) = oq;
            *(unsigned*)(CKVN + row * 128 + 2 * lane) = cvtpk(k0 * rk * gk0, k1 * rk * gk1);
            KIDXN[row * 64 + lane] = (bf16)(cvtpk(xc[q] * ri * gi + bi, 0.f) & 0xffffu);
            if (lane < 4) WIDX[row * 4 + lane] = bf2f(ww[q]) * 0.0625f; }
    }
}

#define MFMA32(a, b, c) __builtin_amdgcn_mfma_f32_32x32x16_bf16((a), (b), (c), 0, 0, 0)
__device__ __forceinline__ s16x4 vtr(const LAS unsigned char* p) { return __builtin_bit_cast(s16x4, __builtin_amdgcn_ds_read_tr16_b64_v4i16((LAS v4i16_t*)p)); }
__device__ __forceinline__ unsigned off_b(unsigned row, unsigned ch) { return 256u * row + 16u * (ch ^ (((row & 3u) << 2) | ((row >> 2) & 3u))); }
__device__ __forceinline__ unsigned ord_key(float s) { unsigned b = __float_as_uint(s); if (b == 0x80000000u) b = 0u; return b ^ ((b >> 31) ? 0xFFFFFFFFu : 0x80000000u); }
__device__ __forceinline__ bf16x8 pack8(const f32x16& x, int s) {
    v4u w; w.x = cvtpk(x[8 * s], x[8 * s + 1]); w.y = cvtpk(x[8 * s + 2], x[8 * s + 3]); w.z = cvtpk(x[8 * s + 4], x[8 * s + 5]); w.w = cvtpk(x[8 * s + 6], x[8 * s + 7]);
    return __builtin_bit_cast(bf16x8, w);
}
__device__ __forceinline__ unsigned wave_prefix_incl(unsigned x, int lane) {
    x += (unsigned)__builtin_amdgcn_update_dpp(0, (int)x, 0x111, 0xf, 0xf, true);
    x += (unsigned)__builtin_amdgcn_update_dpp(0, (int)x, 0x112, 0xf, 0xf, true);
    x += (unsigned)__builtin_amdgcn_update_dpp(0, (int)x, 0x114, 0xf, 0xf, true);
    x += (unsigned)__builtin_amdgcn_update_dpp(0, (int)x, 0x118, 0xf, 0xf, true);
    const unsigned t0 = (unsigned)__builtin_amdgcn_readlane((int)x, 15), t1 = (unsigned)__builtin_amdgcn_readlane((int)x, 31), t2 = (unsigned)__builtin_amdgcn_readlane((int)x, 47);
    const int row = lane >> 4;
    return x + (row >= 1 ? t0 : 0u) + (row >= 2 ? t1 : 0u) + (row >= 3 ? t2 : 0u);
}
constexpr int DSA_SC_OFF = 0, DSA_MASK_OFF = 131072, DSA_KT_OFF = 0;

__device__ __forceinline__ void dsa_select(LAS unsigned char* lds, int b, int qt, const bf16* QIDX, const bf16* KIDXN, const float* WIDX, unsigned* MASKG, int tid, int lane, int wave, int flags, int nb, int nqt, int staged) {
    LAS float* SC = (LAS float*)(lds + DSA_SC_OFF);
    LAS unsigned char* AQS = lds + DSA_MASK_OFF; LAS unsigned char* WQS = lds + DSA_MASK_OFF + 8192;
    const int st_q = tid >> 5, st_hd = (tid & 31) >> 3, st_c = tid & 7, st_i = st_q * 4 + st_hd;
#define SEL_STAGE_LOAD(bb_, q0_) { const size_t nt_ = (size_t)(bb_) * SEQ + (q0_); stv = *(const v4u*)(QIDX + (nt_ + st_q) * 256 + st_hd * 64 + st_c * 8); if (tid < 16) stw = *(const f32x4*)(WIDX + (nt_ + tid) * 4); }
#define SEL_STAGE_WRITE() { *(LAS v4u*)(AQS + st_i * 128 + 16 * (st_c ^ (st_i & 7))) = stv; if (tid < 16) *(LAS f32x4*)(WQS + tid * 16) = stw; }
    v4u stv = (v4u){0u, 0u, 0u, 0u}; f32x4 stw = (f32x4){0.f, 0.f, 0.f, 0.f};
    if (!staged) { SEL_STAGE_LOAD(b, 32 * qt) SEL_STAGE_WRITE() __syncthreads(); }
    const int r = lane & 31, hh = lane >> 5;
    const size_t tokb = (size_t)b * SEQ;
    const int ntile = qt + 1;
    for (int p = 0; p < 2; ++p) {
        const int tq0 = 32 * qt + 16 * p;
        {
            bf16x8 Aq[2][4]; f32x4 wq[2][4];
#pragma unroll
            for (int rt = 0; rt < 2; ++rt) {
#pragma unroll
                for (int s = 0; s < 4; ++s) Aq[rt][s] = *(const LAS bf16x8*)(AQS + (32 * rt + r) * 128 + 16 * ((2 * s + hh) ^ (r & 7)));
#pragma unroll
                for (int g = 0; g < 4; ++g) wq[rt][g] = *(const LAS f32x4*)(WQS + (8 * rt + 2 * g + hh) * 16);
            }
            bf16x8 B0[2][4], B1[2][4];
#define IDX_LOAD(B, Tb) { _Pragma("unroll") for (int tt = 0; tt < 2; ++tt) { const int T = (Tb) + 8 * tt; if (T < ntile) { \
                _Pragma("unroll") for (int s = 0; s < 4; ++s) B[tt][s] = *(const bf16x8*)(KIDXN + (tokb + 32 * T + r) * 64 + 16 * s + 8 * hh); } } }
#define IDX_COMP(B, Tb) { _Pragma("unroll") for (int tt = 0; tt < 2; ++tt) { const int T = (Tb) + 8 * tt; if (T < ntile) { \
                _Pragma("unroll") for (int rt = 0; rt < 2; ++rt) { \
                    f32x16 acc; \
                    _Pragma("unroll") for (int i = 0; i < 16; ++i) acc[i] = 0.f; \
                    _Pragma("unroll") for (int s = 0; s < 4; ++s) acc = MFMA32(Aq[rt][s], B[tt][s], acc); \
                    _Pragma("unroll") for (int g = 0; g < 4; ++g) { \
                        const float sc = (fmaxf(acc[4 * g], 0.f) * wq[rt][g][0] + fmaxf(acc[4 * g + 1], 0.f) * wq[rt][g][1]) + (fmaxf(acc[4 * g + 2], 0.f) * wq[rt][g][2] + fmaxf(acc[4 * g + 3], 0.f) * wq[rt][g][3]); \
                        SC[(8 * rt + 2 * g + hh) * 2048 + 32 * T + r] = sc + 0.0f;     \
                    } } } } }
            IDX_LOAD(B0, wave) IDX_LOAD(B1, wave + 16)
            for (int T0 = wave; T0 < ntile; T0 += 32) {
                IDX_COMP(B0, T0) IDX_LOAD(B0, T0 + 32)
                IDX_COMP(B1, T0 + 16) IDX_LOAD(B1, T0 + 48)
            }
#undef IDX_LOAD
#undef IDX_COMP
        }
        __syncthreads();
        const bool stage_next = (p == 0) || (nqt >= 0);
        if (stage_next) { if (p == 0) SEL_STAGE_LOAD(b, 32 * qt + 16) else SEL_STAGE_LOAD(nb, 32 * nqt) }
        if (!(flags & 8)) {
            const int ta = tq0 + wave, tb = ta + 8;
            unsigned ka[32], kb[32];
#pragma unroll
            for (int i = 0; i < 32; ++i) { const unsigned ba = __float_as_uint(SC[wave * 2048 + lane + 64 * i]), bb = __float_as_uint(SC[(wave + 8) * 2048 + lane + 64 * i]);
                ka[i] = (ba ^ ((unsigned)((int)ba >> 31) | 0x80000000u)) >> 2; kb[i] = (bb ^ ((unsigned)((int)bb >> 31) | 0x80000000u)) >> 2; }
            { const int ia = ta >> 6, ib = tb >> 6;
#pragma unroll
              for (int g = 0; g < 8; ++g) {
                  if (4 * g + 3 >= ia) {
#pragma unroll
                      for (int i = 4 * g; i < 4 * g + 4; ++i) { if (i > ia) ka[i] = 0u; else if (i == ia) ka[i] = (lane <= ta - 64 * i) ? ka[i] : 0u; } }
                  if (4 * g + 3 >= ib) {
#pragma unroll
                      for (int i = 4 * g; i < 4 * g + 4; ++i) { if (i > ib) kb[i] = 0u; else if (i == ib) kb[i] = (lane <= tb - 64 * i) ? kb[i] : 0u; } }
              } }
            __syncthreads();
            LAS unsigned* H = (LAS unsigned*)lds + wave * 3072;
            LAS unsigned* CL = H + 1024;
#define RS_FIND(bin, above, inb) { unsigned c[16]; \
                _Pragma("unroll") for (int j = 0; j < 4; ++j) { const v4u hv = *(const LAS v4u*)(H + 16 * lane + 4 * j); c[4 * j] = hv.x; c[4 * j + 1] = hv.y; c[4 * j + 2] = hv.z; c[4 * j + 3] = hv.w; } \
                unsigned sl = 0u; \
                _Pragma("unroll") for (int j = 0; j < 16; ++j) sl += c[j]; \
                const unsigned pin = wave_prefix_incl(sl, lane); \
                const unsigned S = (unsigned)__builtin_amdgcn_readlane((int)pin, 63) - pin;     \
                const bool hit = ((int)S < need) && ((int)(S + sl) >= need); \
                unsigned run = S; int fbin = 0; unsigned fab = 0u, fin = 0u; bool found = false; \
                _Pragma("unroll") for (int j = 15; j >= 0; --j) { const bool here = !found && ((int)(run + c[j]) >= need); fbin = here ? j : fbin; fab = here ? run : fab; fin = here ? c[j] : fin; found = found || here; run += c[j]; } \
                const int hl = __ffsll((unsigned long long)__ballot(hit)) - 1; \
                bin = (unsigned)__builtin_amdgcn_readlane(16 * lane + fbin, hl); above = (unsigned)__builtin_amdgcn_readlane((int)fab, hl); inb = (unsigned)__builtin_amdgcn_readlane((int)fin, hl); }
#define RS_ZERO() { _Pragma("unroll") for (int j = 0; j < 4; ++j) *(LAS v4u*)(H + 16 * lane + 4 * j) = (v4u){0u, 0u, 0u, 0u}; }
#pragma unroll
            for (int qi = 0; qi < 2; ++qi) {
                const int t = qi ? tb : ta;
                unsigned T = 1u; int sh = 0, need = 0; bool allties = true;
                if (t + 1 > 256) { allties = false;
                    const int ngrp = (t >> 8) + 1;
                    unsigned prefix, bin, above, inb; need = 256;
                    sh = 20; RS_ZERO()
#pragma unroll
                    for (int g = 0; g < 8; ++g) if (g < ngrp) {
#pragma unroll
                        for (int i = 4 * g; i < 4 * g + 4; ++i) { const unsigned kk = qi ? kb[i] : ka[i];
                            __hip_atomic_fetch_add(H + (kk >> 20), 1u, __ATOMIC_RELAXED, __HIP_MEMORY_SCOPE_WORKGROUP); }
                    }
                    RS_FIND(bin, above, inb)
                    prefix = bin; need -= (int)above;
                    if ((int)inb == need) allties = true;
                    else {
                        int nC = 0;
#pragma unroll
                        for (int g = 0; g < 8; ++g) if (g < ngrp) {
#pragma unroll
                            for (int i = 4 * g; i < 4 * g + 4; ++i) { const unsigned kk = qi ? kb[i] : ka[i]; const bool m_ = (kk >> 20) == bin; const unsigned long long bal = __ballot(m_);
                                const int pos = nC + (int)__builtin_amdgcn_mbcnt_hi((unsigned)(bal >> 32), __builtin_amdgcn_mbcnt_lo((unsigned)bal, 0u));
                                if (m_) CL[pos] = kk & 0xFFFFFu;
                                nC += __popcll(bal); }
                        }
                        const int nreg = (nC + 63) >> 6;
                        sh = 10; RS_ZERO()
                        LDS_WAIT(); asm volatile("" ::: "memory");
                        for (int j = 0; j < nreg; ++j) { const int ix = 64 * j + lane; if (ix < nC) __hip_atomic_fetch_add(H + (CL[ix] >> 10), 1u, __ATOMIC_RELAXED, __HIP_MEMORY_SCOPE_WORKGROUP); }
                        RS_FIND(bin, above, inb)
                        prefix = (prefix << 10) | bin; need -= (int)above;
                        if ((int)inb == need) allties = true;
                        else {
                            const unsigned b1 = bin;
                            sh = 0; RS_ZERO()
                            for (int j = 0; j < nreg; ++j) { const int ix = 64 * j + lane; const unsigned v = (ix < nC) ? CL[ix] : 0xFFFFFFFFu; const bool m_ = (v >> 10) == b1;
                                if (__any(m_)) { if (m_) __hip_atomic_fetch_add(H + (v & 1023u), 1u, __ATOMIC_RELAXED, __HIP_MEMORY_SCOPE_WORKGROUP); } }
                            RS_FIND(bin, above, inb)
                            prefix = (prefix << 10) | bin; need -= (int)above;
                            if ((int)inb == need) allties = true;
                        }
                    }
                    T = prefix;
                }
                unsigned mlo = 0u, mhi = 0u;
                if (allties) {
#pragma unroll
                    for (int i = 0; i < 32; ++i) { const unsigned long long sel = __ballot(((qi ? kb[i] : ka[i]) >> sh) >= T);
                        asm volatile("s_nop 3\n\tv_writelane_b32 %0, %2, %4\n\tv_writelane_b32 %1, %3, %4" : "+v"(mlo), "+v"(mhi) : "s"((unsigned)sel), "s"((unsigned)(sel >> 32)), "n"(i)); }
                } else {
                    int runt = 0;
#pragma unroll
                    for (int i = 0; i < 32; ++i) {
                        const unsigned kk = (qi ? kb[i] : ka[i]) >> sh;
                        const bool tie = (kk == T); const unsigned long long tm = __ballot(tie);
                        const int below = (int)__builtin_amdgcn_mbcnt_hi((unsigned)(tm >> 32), __builtin_amdgcn_mbcnt_lo((unsigned)tm, 0u));
                        const unsigned long long sel = __ballot((kk > T) || (tie && (runt + below < need)));
                        runt += __popcll(tm);
                        asm volatile("s_nop 3\n\tv_writelane_b32 %0, %2, %4\n\tv_writelane_b32 %1, %3, %4" : "+v"(mlo), "+v"(mhi) : "s"((unsigned)sel), "s"((unsigned)(sel >> 32)), "n"(i));
                    }
                }
                if (lane < 32) { v2u mv; mv.x = mlo; mv.y = mhi; *(v2u*)(MASKG + (tokb + tq0 + wave + 8 * qi) * 64 + 2 * lane) = mv; }
            }
        }
        if (stage_next) SEL_STAGE_WRITE()
        __syncthreads();
    }
#undef SEL_STAGE_LOAD
#undef SEL_STAGE_WRITE
}

#undef RS_FIND
#undef RS_ZERO
__device__ __forceinline__ float halfmax(float v) {
    auto rr = __builtin_amdgcn_permlane32_swap(__float_as_uint(v), __float_as_uint(v), false, false);
    return fmaxf(__uint_as_float(rr[0]), __uint_as_float(rr[1]));
}
__device__ __forceinline__ float max16(const f32x16& p) {
    float a = fmaxf(fmaxf(p[0], p[1]), p[2]), b = fmaxf(fmaxf(p[3], p[4]), p[5]);
    a = fmaxf(fmaxf(a, p[6]), p[7]); b = fmaxf(fmaxf(b, p[8]), p[9]); a = fmaxf(fmaxf(a, p[10]), p[11]); b = fmaxf(fmaxf(b, p[12]), p[13]);
    return fmaxf(fmaxf(a, b), fmaxf(p[14], p[15]));
}
__device__ __forceinline__ void dsa_attn(LAS unsigned char* lds, int b, int qt, const unsigned* MASKG, const bf16* QLAT, const bf16* CKVN, const bf16* WUVT, bf16* ODSA, int tid, int lane, int wave, int vflags) {
    LAS unsigned* MASK = (LAS unsigned*)(lds + DSA_MASK_OFF);
    const size_t tokb = (size_t)b * SEQ;
    { const v4u mv = *(const v4u*)(MASKG + (tokb + 32 * qt) * 64 + 4 * tid); *(LAS v4u*)(MASK + 4 * tid) = mv; }
    const int r = lane & 31, hh = lane >> 5;
    const int tq = 32 * qt + r; const size_t tok = tokb + tq;
    const int nT = (qt >> 1) + 1;
    bf16x8 Qf[8];
#pragma unroll
    for (int s = 0; s < 8; ++s) Qf[s] = *(const bf16x8*)(QLAT + tok * 1024 + wave * 128 + 16 * s + 8 * hh);
    f32x16 O[4];
#pragma unroll
    for (int ct = 0; ct < 4; ++ct)
#pragma unroll
        for (int i = 0; i < 16; ++i) O[ct][i] = 0.f;
    float m = 0.f, l = 0.f; bool started = false;
    const float slope2 = __builtin_amdgcn_exp2f(-(float)(wave + 1)) * LOG2E;
    const int srow = tid >> 4, sch = tid & 15;
    const unsigned so0 = off_b(srow, sch), so1 = off_b(srow + 32, sch);
    const bf16* gsrc = CKVN + (tokb + srow) * 128 + sch * 8;
    const unsigned xr = ((r & 3u) << 2) | ((r >> 2) & 3u);
    const int q4 = (lane & 15) >> 2, p4 = lane & 3, b16 = (lane >> 4) & 1;
    v4u sa, sb;
#define DA_LOADT(tt) { sa = *(const v4u*)(gsrc + (size_t)(tt) * 8192); sb = *(const v4u*)(gsrc + (size_t)(tt) * 8192 + 4096); }
#define DA_WRITET(bo) { *(LAS v4u*)(lds + (bo) + so0) = sa; *(LAS v4u*)(lds + (bo) + so1) = sb; }
#define DA_KREAD(hf, bo, s0) { const LAS unsigned char* kt_ = lds + (bo) + 8192 * (hf); \
        _Pragma("unroll") for (int s = 0; s < 4; ++s) kf[s] = *(const LAS bf16x8*)(kt_ + 256u * r + 16u * ((unsigned)(2 * ((s0) + s) + hh) ^ xr)); }
#define DA_INIT(tt, hf, P) { const float fb_ = -slope2 * (float)(tq - 64 * (tt) - 32 * (hf) - 4 * hh) - m; \
        const int m_ = (int)(MASK[r * 64 + 2 * (tt) + (hf)] >> (4 * hh)); \
        _Pragma("unroll") for (int i = 0; i < 16; ++i) { const int cr = (i & 3) + 8 * (i >> 2); const unsigned k_ = (unsigned)__builtin_amdgcn_sbfe(m_, cr, 1); \
            P[i] = __uint_as_float((__float_as_uint(fb_ + slope2 * (float)cr) & k_) | (0xFF800000u & ~k_)); } }
#define DA_SMMA(P, s0) { _Pragma("unroll") for (int s = 0; s < 4; ++s) P = MFMA32(kf[s], Qf[(s0) + s], P); }
#define DA_SOFT(P) { const float tmax_ = halfmax(max16(P)); const bool fresh_ = !started && (tmax_ > -INFINITY); \
        if (__any(fresh_ || (tmax_ > 8.0f))) { const float d_ = fresh_ ? tmax_ : fmaxf(tmax_, 0.f), alpha_ = fresh_ ? 1.0f : __builtin_amdgcn_exp2f(-d_); m += d_; l *= alpha_; \
            _Pragma("unroll") for (int ct = 0; ct < 4; ++ct) O[ct] = O[ct] * alpha_; \
            _Pragma("unroll") for (int i = 0; i < 16; ++i) P[i] -= d_; } \
        started = started || (tmax_ > -INFINITY); \
        float ls_ = 0.f; \
        _Pragma("unroll") for (int i = 0; i < 16; ++i) { const float e_ = __builtin_amdgcn_exp2f(P[i]); P[i] = e_; ls_ += e_; } \
        l += ls_; pf[0] = pack8(P, 0); pf[1] = pack8(P, 1); }
#define DA_VREAD(hf, bo, ks) { const LAS unsigned char* vt_ = lds + (bo) + 8192 * (hf); \
        _Pragma("unroll") for (int ct = 0; ct < 4; ++ct) { \
            const s16x4 lo_ = vtr(vt_ + off_b(16 * (ks) + 4 * hh + q4, 4 * ct + 2 * b16 + (p4 >> 1)) + 8 * (p4 & 1)); \
            const s16x4 hi_ = vtr(vt_ + off_b(16 * (ks) + 8 + 4 * hh + q4, 4 * ct + 2 * b16 + (p4 >> 1)) + 8 * (p4 & 1)); \
            vf[ct] = (bf16x8){lo_[0], lo_[1], lo_[2], lo_[3], hi_[0], hi_[1], hi_[2], hi_[3]}; } }
#define DA_PVMMA(ks) { _Pragma("unroll") for (int ct = 0; ct < 4; ++ct) O[ct] = MFMA32(vf[ct], pf[ks], O[ct]); }
#define DA_SB() __builtin_amdgcn_sched_barrier(0)
    bf16x8 kf[4], vf[4], pf[2];
    DA_LOADT(0) DA_WRITET(0)
    if (nT > 1) DA_LOADT(1)
    f32x16 pA;
    const bool halflast = !(qt & 1);
#define DA_TILE(t, oP, oW) { \
        __syncthreads();                                              \
        if ((t) + 1 < nT) { DA_WRITET(oW) if ((t) + 2 < nT) DA_LOADT((t) + 2) } \
        _Pragma("unroll") for (int hf = 0; hf < 2; ++hf) { \
            if (hf == 1 && halflast && (t) + 1 >= nT) break;            \
            if (!(vflags & 128)) DA_KREAD(hf, oP, 0) \
            if (!(vflags & 256)) DA_INIT(t, hf, pA) else { _Pragma("unroll") for (int i = 0; i < 16; ++i) pA[i] = 0.f; } \
            DA_SB(); if (!(vflags & 128)) { DA_SMMA(pA, 0) DA_KREAD(hf, oP, 4) DA_SB(); DA_SMMA(pA, 4) } \
            if (!(vflags & 32)) DA_SOFT(pA) else { pf[0] = pack8(pA, 0); pf[1] = pack8(pA, 1); } \
            if (!(vflags & 64)) { DA_VREAD(hf, oP, 0) DA_SB(); DA_PVMMA(0) DA_VREAD(hf, oP, 1) DA_SB(); DA_PVMMA(1) } } }
    for (int t = 0; t < nT; t += 2) { DA_TILE(t, 0, 16384) if (t + 1 < nT) DA_TILE(t + 1, 16384, 0) }
#undef DA_TILE
#undef DA_KREAD
#undef DA_INIT
#undef DA_SMMA
#undef DA_SOFT
#undef DA_VREAD
#undef DA_PVMMA
#undef DA_SB
#undef DA_LOADT
#undef DA_WRITET
    l += __shfl_xor(l, 32);
    const float inv = 1.0f / l;
    f32x16 Y[2];
#pragma unroll
    for (int dt = 0; dt < 2; ++dt)
#pragma unroll
        for (int i = 0; i < 16; ++i) Y[dt][i] = 0.f;
    int woff = (wave * 64 + r) * 128 + 8 * hh; asm volatile("" : "+v"(woff));
    const bf16* wrow = WUVT + woff;
#pragma unroll
    for (int ct = 0; ct < 4; ++ct)
#pragma unroll
        for (int sx = 0; sx < 2; ++sx) {
            const bf16x8 of = pack8(O[ct], sx);
#pragma unroll
            for (int dt = 0; dt < 2; ++dt) {
                const v4u aw = *(const v4u*)(wrow + (size_t)dt * 32 * 128 + 32 * ct + 16 * sx);
                Y[dt] = MFMA32(__builtin_bit_cast(bf16x8, aw), of, Y[dt]);
            }
        }
    bf16* orow = ODSA + tok * 512 + wave * 64;
#pragma unroll
    for (int dt = 0; dt < 2; ++dt)
#pragma unroll
        for (int g = 0; g < 4; ++g) {
            v2u w; w.x = cvtpk(Y[dt][4 * g] * inv, Y[dt][4 * g + 1] * inv); w.y = cvtpk(Y[dt][4 * g + 2] * inv, Y[dt][4 * g + 3] * inv);
            *(v2u*)(orow + 32 * dt + 8 * g + 4 * hh) = w;
        }
    __syncthreads();
}

__device__ __forceinline__ void kmean_phase(LAS unsigned char* lds, const bf16* P, float* KMG, int bx, int G, int tid) {
    LAS float* PART = (LAS float*)lds;
    for (int bn = bx; bn < BATCH * 8; bn += G) {
        const int rg = tid >> 7, c4 = (tid & 127) * 4;
        const bf16* src = P + ((size_t)bn * 256 + 64 * rg) * PW + PC_MK + c4;
        float a0 = 0.f, a1 = 0.f, a2 = 0.f, a3 = 0.f;
        for (int r0 = 0; r0 < 64; r0 += 16) {
            v2u w[16];
#pragma unroll
            for (int i = 0; i < 16; ++i) w[i] = *(const v2u*)(src + (size_t)(r0 + i) * PW);
#pragma unroll
            for (int i = 0; i < 16; ++i) { a0 += wlo(w[i].x); a1 += whi(w[i].x); a2 += wlo(w[i].y); a3 += whi(w[i].y); }
        }
        *(LAS f32x4*)(PART + rg * 512 + c4) = (f32x4){a0, a1, a2, a3};
        __syncthreads();
        { const float t = (PART[tid] + PART[512 + tid]) + (PART[1024 + tid] + PART[1536 + tid]); KMG[(size_t)bn * 512 + tid] = t * (1.0f / 256.0f); }
        __syncthreads();
    }
}

__device__ __forceinline__ void moba_bh(LAS unsigned char* lds, int b, int h, const bf16* P, const float* KMG, bf16* OM, int tid, int lane, int wave, int vflags) {
    LAS float* KM = (LAS float*)(lds);
    LAS unsigned char* QS = (LAS unsigned char*)(lds + 2048);
    constexpr int KOFF = 24576, VOFF = 40960;
    const int r = lane & 31, hh = lane >> 5;
    const size_t tokb = (size_t)b * SEQ;
    const bf16* MQ = P + PC_MQ + h * 64; const bf16* MK = P + PC_MK + h * 64; const bf16* MV = P + PC_MV + h * 64;
    const float slope2 = __builtin_amdgcn_exp2f(-(float)(h + 1)) * LOG2E;
    const int q4 = (lane & 15) >> 2, p4 = lane & 3, b16 = (lane >> 4) & 1;
    const int srow = tid >> 3, sch = tid & 7;
    const unsigned kso = 128u * srow + 16u * (sch ^ ((srow >> 1) & 7)), vso = 128u * srow + 16u * (sch ^ (((srow >> 1) & 1) << 2));
    const unsigned kro = 128u * r, kx = (r >> 1) & 7;
    KM[tid] = KMG[((size_t)b * 8 + (tid >> 6)) * 512 + h * 64 + (tid & 63)];
    __syncthreads();
    if (wave > 0) {
        bf16x8 Ah[4], Al[4];
#pragma unroll
        for (int s = 0; s < 4; ++s) {
#pragma unroll
            for (int j = 0; j < 8; j += 2) { const float v0 = (r < 8) ? KM[r * 64 + 16 * s + 8 * hh + j] : 0.f, v1 = (r < 8) ? KM[r * 64 + 16 * s + 8 * hh + j + 1] : 0.f;
                const unsigned hi = cvtpk(v0, v1); const float h0 = __uint_as_float(hi << 16), h1 = __uint_as_float(hi & 0xffff0000u); const unsigned lo = cvtpk(v0 - h0, v1 - h1);
                Ah[s][j] = (short)(hi & 0xffffu); Ah[s][j + 1] = (short)(hi >> 16); Al[s][j] = (short)(lo & 0xffffu); Al[s][j + 1] = (short)(lo >> 16); }
        }
        const int blkq = wave;
        bf16x8 Bq[8][4];
#pragma unroll
        for (int g = 0; g < 8; ++g)
#pragma unroll
            for (int s = 0; s < 4; ++s) Bq[g][s] = *(const bf16x8*)(MQ + (tokb + 256 * wave + 32 * g + r) * PW + 16 * s + 8 * hh);
#pragma unroll
        for (int g = 0; g < 8; ++g) {
            const int qn = 256 * wave + 32 * g + r;
            f32x16 acc;
#pragma unroll
            for (int i = 0; i < 16; ++i) acc[i] = 0.f;
#pragma unroll
            for (int s = 0; s < 4; ++s) { acc = MFMA32(Ah[s], Bq[g][s], acc); acc = MFMA32(Al[s], Bq[g][s], acc); }
            float gate[8];
#pragma unroll
            for (int i = 0; i < 4; ++i) { const float own = acc[i], oth = __shfl_xor(own, 32); gate[i] = hh ? oth : own; gate[4 + i] = hh ? own : oth; }
#pragma unroll
            for (int n = 0; n < 7; ++n) gate[n] = (n < blkq) ? gate[n] : -INFINITY;
            unsigned taken = 0u;
#pragma unroll
            for (int pick = 0; pick < 3; ++pick) { float bv = -INFINITY; int best = -1;
#pragma unroll
                for (int n = 0; n < 7; ++n) { const bool ok = !((taken >> n) & 1u) && gate[n] > bv; bv = ok ? gate[n] : bv; best = ok ? n : best; }
                if (best >= 0) taken |= 1u << best; }
            if (hh == 0) QS[qn] = (unsigned char)taken;
        }
    } else { for (int qn = lane; qn < 256; qn += 64) QS[qn] = (unsigned char)0; }
    __syncthreads();
    bf16x8 Qf[4];
    const bf16* ksrc = MK + (tokb + srow) * PW + sch * 8; const bf16* vsrc = MV + (tokb + srow) * PW + sch * 8;
    v4u sk = *(const v4u*)ksrc, sv = *(const v4u*)vsrc;
#pragma unroll
    for (int s = 0; s < 4; ++s) Qf[s] = *(const bf16x8*)(MQ + (tokb + 32 * wave + r) * PW + 16 * s + 8 * hh);
    for (int blk = 0; blk < 8; ++blk) {
        const int tq = 256 * blk + 32 * wave + r; const size_t tok = tokb + tq;
        const unsigned selq = QS[tq];
        f32x16 O[2];
#pragma unroll
        for (int ct = 0; ct < 2; ++ct)
#pragma unroll
            for (int i = 0; i < 16; ++i) O[ct][i] = 0.f;
        float m = 0.f, l = 0.f;
        const int ntl = 4 * (blk + 1);
        bf16x8 kf[4], vf[4], pf[2]; f32x16 pa;
#define MB_HALF(gT, hf, bo) { const int j_ = (gT) >> 2, kh_ = 2 * ((gT) & 3) + (hf); \
            const bool own_ = (j_ == blk); const bool lsel_ = own_ ? true : (((selq >> j_) & 1u) != 0u); \
            const bool act_ = own_ ? (kh_ <= wave) : (__any(lsel_) != 0); \
            if (act_ && !(vflags & 512)) { const LAS unsigned char* kt_ = lds + KOFF + (bo) + 4096 * (hf); const LAS unsigned char* vt_ = lds + VOFF + (bo) + 4096 * (hf); \
                _Pragma("unroll") for (int s = 0; s < 4; ++s) kf[s] = *(const LAS bf16x8*)(kt_ + kro + 16u * ((unsigned)(2 * s + hh) ^ kx)); \
                const float fb_ = lsel_ ? (-slope2 * (float)(tq - 64 * (gT) - 32 * (hf) - 4 * hh) - m) : -INFINITY; \
                const bool diag_ = own_ && (kh_ == wave); \
                _Pragma("unroll") for (int i = 0; i < 16; ++i) { const int cr = (i & 3) + 8 * (i >> 2); pa[i] = fb_ + slope2 * (float)cr; } \
                if (diag_) { _Pragma("unroll") for (int i = 0; i < 16; ++i) { const int cr = (i & 3) + 8 * (i >> 2); pa[i] = (cr + 4 * hh <= r) ? pa[i] : -INFINITY; } } \
                _Pragma("unroll") for (int s = 0; s < 4; ++s) pa = MFMA32(kf[s], Qf[s], pa); \
                const float tmax_ = halfmax(max16(pa));                        \
                if (__any(tmax_ > 8.0f)) { const float d_ = fmaxf(tmax_, 0.f), alpha_ = __builtin_amdgcn_exp2f(-d_); m += d_; l *= alpha_; O[0] = O[0] * alpha_; O[1] = O[1] * alpha_; \
                    _Pragma("unroll") for (int i = 0; i < 16; ++i) pa[i] -= d_; } \
                float ls_ = 0.f; \
                _Pragma("unroll") for (int i = 0; i < 16; ++i) { const float e_ = __builtin_amdgcn_exp2f(pa[i]); pa[i] = e_; ls_ += e_; } \
                l += ls_; pf[0] = pack8(pa, 0); pf[1] = pack8(pa, 1); \
                _Pragma("unroll") for (int ks = 0; ks < 2; ++ks) _Pragma("unroll") for (int ct = 0; ct < 2; ++ct) { \
                    const unsigned r0_ = 16 * ks + 4 * hh + q4, r1_ = r0_ + 8, ch_ = 4 * ct + 2 * b16 + (p4 >> 1); \
                    const s16x4 lo_ = vtr(vt_ + 128u * r0_ + 16u * (ch_ ^ (((r0_ >> 1) & 1u) << 2)) + 8 * (p4 & 1)); \
                    const s16x4 hi_ = vtr(vt_ + 128u * r1_ + 16u * (ch_ ^ (((r1_ >> 1) & 1u) << 2)) + 8 * (p4 & 1)); \
                    vf[ks * 2 + ct] = (bf16x8){lo_[0], lo_[1], lo_[2], lo_[3], hi_[0], hi_[1], hi_[2], hi_[3]}; } \
                _Pragma("unroll") for (int ks = 0; ks < 2; ++ks) _Pragma("unroll") for (int ct = 0; ct < 2; ++ct) O[ct] = MFMA32(vf[ks * 2 + ct], pf[ks], O[ct]); } }
#define MB_TILE(gT, bo) { *(LAS v4u*)(lds + KOFF + (bo) + kso) = sk; *(LAS v4u*)(lds + VOFF + (bo) + vso) = sv; \
            __syncthreads(); \
            { const int nx_ = ((gT) + 1 < ntl) ? (gT) + 1 : 0; sk = *(const v4u*)(ksrc + (size_t)64 * nx_ * PW); sv = *(const v4u*)(vsrc + (size_t)64 * nx_ * PW); } \
            MB_HALF(gT, 0, bo) MB_HALF(gT, 1, bo) }
        for (int gT = 0; gT < ntl; gT += 2) { MB_TILE(gT, 0) MB_TILE(gT + 1, 8192) }
#undef MB_HALF
#undef MB_TILE
        l += __shfl_xor(l, 32);
        const float inv = 1.0f / l;
        if (blk < 7) {
#pragma unroll
            for (int s = 0; s < 4; ++s) Qf[s] = *(const bf16x8*)(MQ + (tok + 256) * PW + 16 * s + 8 * hh);
        }
        bf16* orow = OM + tok * 512 + h * 64;
#pragma unroll
        for (int ct = 0; ct < 2; ++ct)
#pragma unroll
            for (int g = 0; g < 4; ++g) {
                v2u w; w.x = cvtpk(O[ct][4 * g] * inv, O[ct][4 * g + 1] * inv); w.y = cvtpk(O[ct][4 * g + 2] * inv, O[ct][4 * g + 3] * inv);
                *(v2u*)(orow + 32 * ct + 8 * g + 4 * hh) = w;
            }
    }
    __syncthreads();
}

struct Args { const float* in[26]; float* out; unsigned char* ws; int ph_lo, ph_hi, flags, pad; };
__global__ void __launch_bounds__(NWAVES * 64, 2) mk_fwd(Args args) {
    extern __shared__ __attribute__((aligned(16))) unsigned char lds_raw[];
    LAS unsigned char* lds = (LAS unsigned char*)lds_raw;
    volatile LAS unsigned* MISC = (volatile LAS unsigned*)(lds + MISC_OFF);
    const int wave = __builtin_amdgcn_readfirstlane((int)threadIdx.x >> 6);
    const int G = gridDim.x, bx = blockIdx.x;
    const int gw = bx * NWAVES + wave, NGW = G * NWAVES;
    gu32* ctl = (gu32*)(args.ws + WS_CTL);
#define KA_LD(T, off) (*(T const __attribute__((address_space(4)))*)(ka_ + (off)))
#define DECL_PTRS \
    int lane_p_ = lane_id(); asm volatile("" : "+v"(lane_p_)); const int lane = lane_p_, tid = wave * 64 + lane_p_; (void)tid; \
    const __attribute__((address_space(4))) unsigned char* ka_ = (const __attribute__((address_space(4))) unsigned char*)__builtin_amdgcn_kernarg_segment_ptr(); asm volatile("" : "+s"(ka_)); \
    const float* x = KA_LD(const float*, 0); const float* cc = KA_LD(const float*, 8); const float* w_ada = KA_LD(const float*, 16); const float* b_ada = KA_LD(const float*, 24); \
    const float* g_ffn1 = KA_LD(const float*, 32); const float* w1a = KA_LD(const float*, 40); const float* w3a = KA_LD(const float*, 48); const float* w2a = KA_LD(const float*, 56); \
    const float* g_mix = KA_LD(const float*, 64); const float* w_in = KA_LD(const float*, 72); const float* g_cq = KA_LD(const float*, 80); const float* g_ckv = KA_LD(const float*, 88); \
    const float* g_kidx = KA_LD(const float*, 96); const float* b_kidx = KA_LD(const float*, 104); const float* w_uq = KA_LD(const float*, 112); const float* w_qidx = KA_LD(const float*, 120); \
    const float* w_uk = KA_LD(const float*, 128); const float* w_uv = KA_LD(const float*, 136); const float* w_pd = KA_LD(const float*, 144); const float* w_pm = KA_LD(const float*, 152); \
    const float* w_out = KA_LD(const float*, 160); const float* g_ffn2 = KA_LD(const float*, 168); const float* w1b = KA_LD(const float*, 176); const float* w3b = KA_LD(const float*, 184); \
    const float* w2b = KA_LD(const float*, 192); const float* g_final = KA_LD(const float*, 200); \
    float* out = KA_LD(float*, 208); unsigned char* ws = KA_LD(unsigned char*, 216); const int pflags = KA_LD(int, 232); \
    float* MODS = (float*)(ws + WS_MODS); \
    bf16 *WT1A = (bf16*)(ws + WS_WT1A), *W2TA = (bf16*)(ws + WS_W2TA), *WT1B = (bf16*)(ws + WS_WT1B), *W2TB = (bf16*)(ws + WS_W2TB), *WIN = (bf16*)(ws + WS_WIN), *WQ = (bf16*)(ws + WS_WQ), \
         *WPD = (bf16*)(ws + WS_WC), *WUVT = (bf16*)(ws + WS_WC + MiB), *WPM = (bf16*)(ws + WS_WPM), *WOUT = (bf16*)(ws + WS_WOUT); \
    bf16 *CQN = (bf16*)(ws + WS_CQN), *CKVN = (bf16*)(ws + WS_CKVN), *KIDXN = (bf16*)(ws + WS_KIDXN), *QIDX = (bf16*)(ws + WS_QIDX), *OMOBA = (bf16*)(ws + WS_OMOBA); \
    float* WIDX = (float*)(ws + WS_WIDX); \
    bf16 *XN = (bf16*)(ws + WS_XN), *QLAT = XN, *T1 = XN, *ODSA = (bf16*)(ws + WS_OLAT), *Y = XN  , *PB = (bf16*)(ws + WS_P), *U = PB; \
    unsigned *CMAXA = (unsigned*)(ws + 768 * 1024), *CMAXB = (unsigned*)(ws + 800 * 1024), *CMAXW = (unsigned*)(ws + 832 * 1024), *CMAXDA = (unsigned*)(ws + 864 * 1024), *CMAXDB = (unsigned*)(ws + 872 * 1024); unsigned char* U8 = (unsigned char*)PB; bf16* XN8 = (bf16*)(ws + WS_OMOBA);     float* RSU = (float*)(ws + WS_MODS + 1792 * 1024); unsigned long long *CSQA = (unsigned long long*)(ws + 880 * 1024), *CSQB = (unsigned long long*)(ws + 928 * 1024); float *CMX = (float*)(ws + WS_MODS + 2048 * 1024); float* RS = (float*)(ws + WS_MODS + 1536 * 1024);     \
    bf16 *X1 = (bf16*)out, *X2 = (bf16*)out + (size_t)M * D, *X3 = XN;     \
    (void)x; (void)cc; (void)w_ada; (void)b_ada; (void)g_ffn1; (void)w1a; (void)w3a; (void)w2a; (void)g_mix; (void)w_in; (void)g_cq; (void)g_ckv; (void)g_kidx; (void)b_kidx; (void)w_uq; (void)w_qidx; (void)w_uk; (void)w_uv; \
    (void)w_pd; (void)w_pm; (void)w_out; (void)g_ffn2; (void)w1b; (void)w3b; (void)w2b; (void)g_final; (void)out; (void)pflags; (void)MODS; (void)WT1A; (void)W2TA; (void)WT1B; (void)W2TB; (void)WIN; (void)WQ; (void)WPD; (void)WUVT; (void)WPM; (void)WOUT; \
    (void)CQN; (void)CKVN; (void)KIDXN; (void)QIDX; (void)OMOBA; (void)WIDX; (void)XN; (void)QLAT; (void)T1; (void)ODSA; (void)Y; (void)PB; (void)U; (void)X1; (void)X2; (void)X3; (void)CMAXA; (void)CMAXB; (void)CMAXW; (void)CMAXDA; (void)CMAXDB; (void)U8; (void)XN8; (void)RSU; (void)RS; (void)CSQA; (void)CSQB; (void)CMX;

    for (int u = threadIdx.x; u < (LDS_BYTES - LDSCTL_OFF) / 4; u += NWAVES * 64) ((LAS unsigned*)(lds + LDSCTL_OFF))[u] = 0u;
    __syncthreads();
    XcdBarrier bar; bar.bar = (unsigned*)(ctl + CW_BAR); bar.x = 0; bar.st = nullptr;
    if (MK_ONE_LAUNCH) bar = xcd_barrier_post((unsigned*)(ctl + CW_BAR), MISC + 8);
    const int lo = args.ph_lo, hi = args.ph_hi;
    const bool grp = (G == 256);
#define GRP_VARS const int g8 = bx & 7, j32 = bx >> 3; const int vbx = grp ? 32 * g8 + j32 : bx;   \
    const int rbase = grp ? 8192 * g8 : 0, rrows = grp ? 8192 : M, lw = grp ? j32 * 8 + wave : gw, nlw = grp ? 256 : NGW; (void)vbx; (void)rbase; (void)rrows; (void)lw; (void)nlw;
    if (MK_ONE_LAUNCH && grp && threadIdx.x == 0) (void)__hip_atomic_fetch_or((unsigned*)ctl + 14336 + 64 * (bx & 7), 1u << bar.x, __ATOMIC_RELAXED, __HIP_MEMORY_SCOPE_AGENT);
#define IN(k) (lo <= (k) && (k) < hi)
#define SEAM(k) do { if (IN(k) && IN((k) + 1)) { \
        if (grp && lo == 0 && hi == NPHASE && (k) >= 2 && (k) <= 13) { unsigned* gcnt_ = (unsigned*)ctl + 12288 + 64 * (bx & 7); \
            if ((k) == 2 && threadIdx.x == 0) MISC[12] = (__builtin_popcount(xb_ld((unsigned*)ctl + 14336 + 64 * (bx & 7))) == 1) ? 1u : 0u; \
            grp_barrier((unsigned*)(ctl + CW_BAR), gcnt_, 32u * (unsigned)((k) - 1 - ((k) > 9 ? 1 : 0)), (k) > 2 ? (MISC[12] != 0u) : false); } \
        else xcd_barrier(bar); } } while (0)

    if (IN(0)) { DECL_PTRS
        LAS float* scr = (LAS float*)(lds + wave * 16384);
        const int n2g = MODW / 32 - G; const bool resplit = (n2g > 0 && 2 * n2g < G);
        const int istr = resplit ? (G - n2g) * NWAVES : NGW;
        int it = resplit ? (bx < n2g ? 0x3fffffff : (bx - n2g) * NWAVES + wave) : gw, base = 0;
#define JOB(Wp, Nsrc, col0, nvalid_, ntotal_, Kdim, WTp, ldk, rowexpr) { const int nb_ = (ntotal_) / 32, n_ = ((Kdim) / 64) * nb_; \
            for (; it < base + n_; it += istr) { const int loc = it - base, kb = loc / nb_, n0 = (loc % nb_) * 32; const int nv = ((nvalid_) - n0) < 32 ? ((nvalid_) - n0) : 32; \
                tr_item(Wp, Nsrc, (col0) + n0, nv, kb * 64, WTp, ldk, (rowexpr), scr, lane, JOB_SCALE); } base += n_; }
#define JOB_SCALE 1.0f
#define JOBMAX(Wp, CMp, CSp, rowexpr) { const int nb_ = FF / 32, n_ = (D / 64) * nb_; \
            for (; it < base + n_; it += istr) { const int loc = it - base, kb = loc / nb_, n0 = (loc % nb_) * 32; colmax_item(Wp, FF, n0, kb * 64, CMp, (rowexpr), lane, 32, CSp); } base += n_; }
        JOBMAX(w1a, CMAXA, CSQA, (n0 / 128) * 256 + (n0 % 128))
        JOBMAX(w3a, CMAXA, CSQA, (n0 / 128) * 256 + 128 + (n0 % 128))
        JOBMAX(w1b, CMAXB, CSQB, (n0 / 128) * 256 + (n0 % 128))
        JOBMAX(w3b, CMAXB, CSQB, (n0 / 128) * 256 + 128 + (n0 % 128))
#undef JOBMAX
#define JOBMAX2(Wp, CMp) { const int nb_ = D / 32, n_ = (FF / 64) * nb_; \
            for (; it < base + n_; it += istr) { const int loc = it - base, kb = loc / nb_, n0 = (loc % nb_) * 32; colmax_item(Wp, D, n0, kb * 64, CMp, n0, lane); } base += n_; }
        JOBMAX2(w2a, CMAXDA) JOBMAX2(w2b, CMAXDB)
#undef JOBMAX2
#define JOBMAXW(col0, nvalid_, ntotal_, drow0_) { const int nb_ = (ntotal_) / 32, n_ = (D / 64) * nb_; \
            for (; it < base + n_; it += istr) { const int loc = it - base, kb = loc / nb_, n0 = (loc % nb_) * 32; const int nv = ((nvalid_) - n0) < 32 ? ((nvalid_) - n0) : 32; \
                colmax_item(w_in, INW, (col0) + n0, kb * 64, CMAXW, (drow0_) + n0, lane, nv); } base += n_; }
        JOBMAXW(0, 448, 448, 0) JOBMAXW(448, 4, 64, 448) JOBMAXW(452, 3584, 3584, 512)
#undef JOBMAXW
        JOB(w_qidx, 256, 0, 256, 256, 256, WQ, 256, 1024 + n0)
        JOB(w_pm, D, 0, D, D, 512, WPM, 512, n0)
        JOB(w_pd, D, 0, D, D, 512, WPD, 512, n0)
        JOB(w_out, D, 0, D, D, D, WOUT, D, n0)
#undef JOB
#undef JOB_SCALE
        for (; it < base + 512; it += istr) {
            const int jq = it - base, hd = jq >> 6, rq = (jq >> 4) & 3, c0 = (jq & 15) * 8, rr = 64 * rq + lane;
            float av[64];
#pragma unroll
            for (int d4 = 0; d4 < 16; ++d4) { const f32x4 t = *(const f32x4*)(w_uq + (size_t)rr * 512 + hd * 64 + 4 * d4); av[4 * d4] = t.x; av[4 * d4 + 1] = t.y; av[4 * d4 + 2] = t.z; av[4 * d4 + 3] = t.w; }
            float bv[8];
#pragma unroll
            for (int cx = 0; cx < 8; ++cx) bv[cx] = w_uk[(size_t)(c0 + cx) * 512 + hd * 64 + lane];
#pragma unroll
            for (int cx = 0; cx < 8; ++cx) { float sacc = 0.f;
#pragma unroll
                for (int d = 0; d < 64; ++d) sacc += av[d] * __uint_as_float(__builtin_amdgcn_readlane(__float_as_uint(bv[cx]), d));
                WQ[(size_t)(hd * 128 + c0 + cx) * 256 + rr] = (bf16)f2bf(sacc * (0.125f * LOG2E)); }
        }
        base += 512;
        for (int o = bx * 512 + tid; o < 8 * 64 * 128; o += G * 512) { const int hd = o >> 13, d = (o >> 7) & 63, ps = o & 127, j = ps & 7, c = (ps & ~15) + 8 * (j >> 2) + 4 * ((ps >> 3) & 1) + (j & 3);
            WUVT[o] = (bf16)f2bf(w_uv[(size_t)c * 512 + hd * 64 + d]); }
        __syncthreads();
        for (int grp = bx; grp < MODW / 32; grp += G) {
            LAS float* CA = (LAS float*)lds;
            for (int e0 = tid; e0 < BATCH * D; e0 += 512 * 16) {
                float cv[16];
#pragma unroll
                for (int u = 0; u < 16; ++u) cv[u] = cc[e0 + 512 * u];
#pragma unroll
                for (int u = 0; u < 16; ++u) { const int e = e0 + 512 * u, bb = e >> 10, k = e & 1023; const float v = cv[u];
                    CA[k * 32 + (bb ^ ((k & 7) << 2))] = v * __builtin_amdgcn_rcpf(1.0f + __builtin_amdgcn_exp2f(-1.4426950408889634f * v)); }
            }
            __syncthreads();
            const int col = 32 * grp + (lane & 31), kbase = 128 * wave + 64 * (lane >> 5);
            f32x16 macc;
#pragma unroll
            for (int i = 0; i < 16; ++i) macc[i] = 0.f;
#pragma unroll
            for (int kb = 0; kb < 64; kb += 32) {
                float wv[32], av[32];
#pragma unroll
                for (int u = 0; u < 32; ++u) wv[u] = w_ada[(size_t)(kbase + kb + u) * MODW + col];
#pragma unroll
                for (int u = 0; u < 32; ++u) av[u] = CA[(kbase + kb + u) * 32 + ((lane & 31) ^ ((u & 7) << 2))];
#pragma unroll
                for (int u = 0; u < 32; ++u) macc = __builtin_amdgcn_mfma_f32_32x32x2f32(av[u], wv[u], macc, 0, 0, 0);
            }
            __syncthreads();
            LAS float* PART = (LAS float*)lds;
#pragma unroll
            for (int i = 0; i < 16; ++i) { const int bb = (i & 3) + 8 * (i >> 2) + 4 * (lane >> 5); PART[(wave * 32 + bb) * 32 + (lane & 31)] = macc[i]; }
            __syncthreads();
            for (int o = tid; o < 1024; o += 512) { const int bb = o >> 5, cl = o & 31; float t = b_ada[32 * grp + cl];
#pragma unroll
                for (int w8 = 0; w8 < 8; ++w8) t += PART[(w8 * 32 + bb) * 32 + cl];
                MODS[(size_t)bb * MODW + 32 * grp + cl] = t; }
            __syncthreads();
        }
    }
    SEAM(0);
    if (IN(1)) { DECL_PTRS GRP_VARS
      if (wave >= 4) {
        float cmA = 0.f, cmB = 0.f;
#pragma unroll 11
        for (int k = lane; k < FF; k += 64) { const int r1 = (k >> 7) * 256 + (k & 127); cmA = fmaxf(cmA, ((float)CSQA[r1] * 2.3283064365386963e-10f) * ((float)CSQA[r1 + 128] * 2.3283064365386963e-10f)); cmB = fmaxf(cmB, ((float)CSQB[r1] * 2.3283064365386963e-10f) * ((float)CSQB[r1 + 128] * 2.3283064365386963e-10f)); }
#pragma unroll
        for (int o = 1; o < 64; o <<= 1) { cmA = fmaxf(cmA, __shfl_xor(cmA, o)); cmB = fmaxf(cmB, __shfl_xor(cmB, o)); }
        cmA = __builtin_sqrtf(cmA); cmB = __builtin_sqrtf(cmB);
        if (bx == 0 && wave == 4 && lane == 0) { CMX[0] = cmA; CMX[1] = cmB; }
        { LAS float* scr = (LAS float*)(lds + wave * 16384); int it = bx * 4 + (wave - 4), base = 0;
#define JOBQ(Wp, WTp, CMp, rowexpr) { const int nb_ = FF / 32, n_ = (D / 64) * nb_; \
            for (; it < base + n_; it += G * 4) { const int loc = it - base, kb = loc / nb_, n0 = (loc % nb_) * 32; tr_item_q8(Wp, FF, n0, kb * 64, (unsigned char*)(WTp), D, (rowexpr), CMp, scr, lane); } base += n_; }
          JOBQ(w1a, WT1A, CMAXA, (n0 / 128) * 256 + (n0 % 128))
          JOBQ(w3a, WT1A, CMAXA, (n0 / 128) * 256 + 128 + (n0 % 128))
          JOBQ(w1b, WT1B, CMAXB, (n0 / 128) * 256 + (n0 % 128))
          JOBQ(w3b, WT1B, CMAXB, (n0 / 128) * 256 + 128 + (n0 % 128))
#undef JOBQ
#define JOBQW(col0, nvalid_, ntotal_, drow0_) { const int nb_ = (ntotal_) / 32, n_ = (D / 64) * nb_; \
            for (; it < base + n_; it += G * 4) { const int loc = it - base, kb = loc / nb_, n0 = (loc % nb_) * 32; const int nv = ((nvalid_) - n0) < 32 ? ((nvalid_) - n0) : 32; \
                tr_item_q8(w_in, INW, (col0) + n0, kb * 64, (unsigned char*)WIN, D, (drow0_) + n0, CMAXW, scr, lane, nv); } base += n_; }
          JOBQW(0, 448, 448, 0) JOBQW(448, 4, 64, 448) JOBQW(452, 3584, 3584, 512)
#undef JOBQW
#define JOBQ2(Wp, WTp, CMp, CSp, cmx) { const int nb_ = D / 32, n_ = (FF / 64) * nb_; \
            for (; it < base + n_; it += G * 4) { const int loc = it - base, kb = loc / nb_, n0 = (loc % nb_) * 32; tr_item_q8(Wp, D, n0, kb * 64, (unsigned char*)(WTp), FF, n0, CMp, scr, lane, 32, CSp, (cmx) > 0.f ? 1.0f / (cmx) : 0.f); } base += n_; }
          JOBQ2(w2a, W2TA, CMAXDA, CSQA, cmA) JOBQ2(w2b, W2TB, CMAXDB, CSQB, cmB)
#undef JOBQ2
        }
      } else {
        const int lw4 = grp ? j32 * 4 + wave : bx * 4 + wave, nlw4 = grp ? 128 : G * 4;
        normmod_phase<true>(x, g_ffn1, MODS + 0 * D, MODS + 1 * D, XN8, RS, RSU, rbase, rrows, lw4, nlw4, lane); } }
    SEAM(1);
    if (IN(2)) { DECL_PTRS pg8::Gemm g{XN8, WT1A, M, 2 * FF, D / 2, D / 2, XN8, WT1A}; pg8::StaticOrder S; S.init(M, 2 * FF, G, bx); pg8::EpiSwigluQ E{U8, 2 * PW, RS, (const float*)CMAXA, CSQA, RSU};
        pg8::gemm_phase<pg8::EpiSwigluQ, pg8::StaticOrder, true, true, true>(lds, g, S, E, wave); }
    SEAM(2);
    if (IN(3)) { DECL_PTRS
        pg8::Gemm g{(const bf16*)U8, W2TA, M, D, FF / 2, PW, (const bf16*)U8, W2TA}; pg8::StaticOrder S; S.init(M, D, G, bx); pg8::EpiResidB<false, true, true> E{x, X1, D, MODS + 2 * D, MODW, RSU, (const float*)CMAXDA, CMX};
        pg8::gemm_phase<pg8::EpiResidB<false, true, true>, pg8::StaticOrder, true, true, true>(lds, g, S, E, wave); }
    SEAM(3);
    if (IN(4)) { DECL_PTRS GRP_VARS normmod_bf_phase<true>(X1, g_mix, MODS + 3 * D, MODS + 4 * D, XN8, RS, nullptr, rbase, rrows, lw, nlw, lane); }
    SEAM(4);
    if (IN(5)) { DECL_PTRS pg8::Gemm g{XN8, WIN, M, PW, D / 2, D / 2, XN8, WIN}; pg8::StaticOrder S; S.init(M, PW, G, bx); pg8::EpiStoreI8 E{PB, PW, RS, (const float*)CMAXW, 2, 4, 0.125f * LOG2E};
        pg8::gemm_phase<pg8::EpiStoreI8, pg8::StaticOrder, true, true, true>(lds, g, S, E, wave); }
    SEAM(5);
    if (IN(6)) { DECL_PTRS GRP_VARS smallnorm_phase(PB, g_cq, g_ckv, g_kidx, b_kidx, CQN, CKVN, KIDXN, WIDX, rbase, rrows, lw, nlw, lane); kmean_phase(lds, PB, (float*)(ws + WS_KMG), vbx, G, tid); }
    SEAM(6);
    if (IN(7)) { DECL_PTRS pg8::Gemm g{CQN, WQ, M, 1280, 256, 256, CQN, WQ}; pg8::StaticOrder S; S.init(M, 1280, G, bx); pg8::EpiStore2 E{QLAT, 1024, 4, QIDX, 256};
        pg8::gemm_phase<pg8::EpiStore2, pg8::StaticOrder, true, true>(lds, g, S, E, wave); }
    SEAM(7);
    if (IN(8)) { DECL_PTRS GRP_VARS
        unsigned* MASKG = (unsigned*)(ws + WS_MASK);
        if (!(pflags & 1)) {
            for (int idx = bx; idx < BATCH * 64; idx += G) {
                const int i = idx / G, c = idx % G;
                int b, qt;
                if (G == 256) { b = 4 * (c & 7) + ((c >> 3) & 3); const int hi3 = c >> 5; qt = (i & 1) ? (8 * i + 7 - hi3) : (8 * i + hi3); }
                else { b = idx & 31; qt = idx >> 5; }
                int nb = b, nqt = -1;
                if (idx + G < BATCH * 64) { const int i2 = (idx + G) / G; if (G == 256) { const int hi3 = c >> 5; nqt = (i2 & 1) ? (8 * i2 + 7 - hi3) : (8 * i2 + hi3); } else { nb = (idx + G) & 31; nqt = (idx + G) >> 5; } }
                if (!(pflags & 16)) dsa_select(lds, b, qt, QIDX, KIDXN, WIDX, MASKG, tid, lane, wave, pflags, nb, nqt, idx >= G ? 1 : 0);
            }
            asm volatile("s_waitcnt vmcnt(0)" ::: "memory"); __syncthreads();
            if (!(pflags & 4))
            for (int idx = bx; idx < BATCH * 64; idx += G) {
                const int i = idx / G, c = idx % G;
                int b, qt;
                if (G == 256) { b = 4 * (c & 7) + ((c >> 3) & 3); const int hi3 = c >> 5; qt = (i & 1) ? (8 * i + 7 - hi3) : (8 * i + hi3); }
                else { b = idx & 31; qt = idx >> 5; }
                dsa_attn(lds, b, qt, MASKG, QLAT, CKVN, WUVT, ODSA, tid, lane, wave, PROBE_VARIANTS ? pflags : 0);
            }
        }
        if (!(pflags & 2))
        for (int bh = vbx; bh < BATCH * 8; bh += G) moba_bh(lds, bh >> 3, bh & 7, PB, (const float*)(ws + WS_KMG), OMOBA, tid, lane, wave, PROBE_VARIANTS ? pflags : 0);
    }
    SEAM(8);
    if (IN(9)) { DECL_PTRS pg8::Gemm g{ODSA, WPD, M, D, 512, 512, OMOBA, WPM}; pg8::StaticOrder S; S.init(M, D, G, bx); pg8::EpiGate2 E{Y, D, PB + PC_GA, PB + PC_GB, PW};
        pg8::gemm_phase<pg8::EpiGate2, pg8::StaticOrder, true, true, false, true>(lds, g, S, E, wave); }
    SEAM(10);
    if (IN(11)) { DECL_PTRS pg8::Gemm g{Y, WOUT, M, D, D, D, Y, WOUT}; pg8::StaticOrder S; S.init(M, D, G, bx); pg8::EpiResidB<true, false, false> E{X1, X2, D, MODS + 5 * D, MODW, MODS, MODS, MODS};
        pg8::gemm_phase<pg8::EpiResidB<true, false, false>, pg8::StaticOrder, true, true>(lds, g, S, E, wave); }
    SEAM(11);
    if (IN(12)) { DECL_PTRS GRP_VARS normmod_bf_phase<true>(X2, g_ffn2, MODS + 6 * D, MODS + 7 * D, XN8, RS, RSU, rbase, rrows, lw, nlw, lane); }
    SEAM(12);
    if (IN(13)) { DECL_PTRS pg8::Gemm g{XN8, WT1B, M, 2 * FF, D / 2, D / 2, XN8, WT1B}; pg8::StaticOrder S; S.init(M, 2 * FF, G, bx); pg8::EpiSwigluQ E{U8, 2 * PW, RS, (const float*)CMAXB, CSQB, RSU};
        pg8::gemm_phase<pg8::EpiSwigluQ, pg8::StaticOrder, true, true, true>(lds, g, S, E, wave); }
    SEAM(13);
    if (IN(14)) { DECL_PTRS
        pg8::Gemm g{(const bf16*)U8, W2TB, M, D, FF / 2, PW, (const bf16*)U8, W2TB}; pg8::StaticOrder S; S.init(M, D, G, bx); pg8::EpiResidB<true, true, true> E{X2, X3, D, MODS + 8 * D, MODW, RSU, (const float*)CMAXDB, CMX + 1};
        pg8::gemm_phase<pg8::EpiResidB<true, true, true>, pg8::StaticOrder, true, true, true>(lds, g, S, E, wave); }
    SEAM(14);
    if (IN(15)) { DECL_PTRS finalnorm_phase(X3, g_final, out, gw, NGW, lane); }
#undef IN
#undef SEAM
}

extern "C" void kernel_launch(void* const* d_in, const int* in_sizes, int n_in, void* d_out, int out_size, void* d_ws, size_t ws_size, hipStream_t stream) {
    static int grid = 0;
    if (grid == 0) {
        if (n_in != 26 || in_sizes[0] != M * D || out_size != M * D || ws_size < WS_END) { fprintf(stderr, "kernel_launch: unexpected shapes (n_in %d, in0 %d, out %d, ws %zu)\n", n_in, n_in > 0 ? in_sizes[0] : -1, out_size, ws_size); grid = -1; return; }
        int dev = 0, cus = 0, per_cu = 0;
        if (hipGetDevice(&dev) != hipSuccess || hipDeviceGetAttribute(&cus, hipDeviceAttributeMultiprocessorCount, dev) != hipSuccess) { grid = -1; return; }
        if (hipFuncSetAttribute((const void*)mk_fwd, hipFuncAttributeMaxDynamicSharedMemorySize, LDS_BYTES) != hipSuccess) { fprintf(stderr, "kernel_launch: hipFuncSetAttribute failed\n"); grid = -1; return; }
        if (hipOccupancyMaxActiveBlocksPerMultiprocessor(&per_cu, (const void*)mk_fwd, NWAVES * 64, LDS_BYTES) != hipSuccess || per_cu < 1) fprintf(stderr, "kernel_launch: occupancy query reports %d\n", per_cu);
        (void)hipGetLastError();
        grid = cus;
    }
    if (grid < 0) return;
    if (hipMemsetAsync((char*)d_ws + WS_CTL, 0, CTL_ZERO_BYTES, stream) != hipSuccess) return;
    Args a{};
    for (int i = 0; i < 26; ++i) a.in[i] = (const float*)d_in[i];
    a.out = (float*)d_out; a.ws = (unsigned char*)d_ws;
    if (MK_ONE_LAUNCH) { a.ph_lo = 0; a.ph_hi = NPHASE; hipLaunchKernelGGL(mk_fwd, dim3(grid), dim3(NWAVES * 64), LDS_BYTES, stream, a); }
    else for (int p = 0; p < NPHASE; ++p) { a.ph_lo = p; a.ph_hi = p + 1;
#if defined(PROBE_PHASE) && defined(PROBE_BEFORE)
        if (p == PROBE_PHASE) for (int e = 0; e < PROBE_REPS; ++e) { a.flags = PROBE_FLAGS; hipLaunchKernelGGL(mk_fwd, dim3(grid), dim3(NWAVES * 64), LDS_BYTES, stream, a); }
#endif
        a.flags = 0; hipLaunchKernelGGL(mk_fwd, dim3(grid), dim3(NWAVES * 64), LDS_BYTES, stream, a);
#if defined(PROBE_PHASE) && !defined(PROBE_BEFORE)
        if (p == PROBE_PHASE) for (int e = 0; e < PROBE_REPS; ++e) { a.flags = PROBE_FLAGS; hipLaunchKernelGGL(mk_fwd, dim3(grid), dim3(NWAVES * 64), LDS_BYTES, stream, a); }
#endif
    }
}
```
